# Optimizing an MI355X kernel written in HIP

```python
import jax, jax.numpy as jnp
from jax import lax
import numpy as np

D_MODEL = 1024
BATCH = 2
SEQ = 8192
DEPTH = 4

N_MIXERS = 2
N_ATTN = (DEPTH + 1) // 2
N_RWKV = DEPTH // 2
N_MOD = 9
MOD_INIT = 0.5
D_FF = 2816
FFN_RES = 0.5
HEAD_DIM = 128
N_HEADS = D_MODEL // HEAD_DIM
N_KV_HEADS = N_HEADS // 4
GROUP = N_HEADS // N_KV_HEADS
Q_DIM = N_HEADS * HEAD_DIM
KV_DIM = N_KV_HEADS * HEAD_DIM
Q_BLOCK = 128
ROPE_THETA = 10000.0
ROPE_AXIS_DIM = HEAD_DIM // 2
GRID_W = 64
RWKV_N = 64
RWKV_H = D_MODEL // RWKV_N
DECAY_LORA = 64
ICLR_LORA = 64
VRES_LORA = 32
GATE_LORA = 128
LNX_EPS = 64e-5
RMS_EPS = 1e-6
F32 = jnp.float32

kernel_name = "hybrid_gqa_rwkv7_macaron_adaln_encoder"


def rms_norm(x, g, eps=RMS_EPS):
    xf = x.astype(F32)
    y = xf * lax.rsqrt(jnp.mean(xf * xf, axis=-1, keepdims=True) + eps)
    return (y * g.astype(F32)).astype(x.dtype)


def ada_norm(x, g, shift, scale):
    return rms_norm(x, g) * (1 + scale[:, None, :]) + shift[:, None, :]


def swiglu(h, w_gate, w_up, w_down):
    return (jax.nn.silu(h @ w_gate) * (h @ w_up)) @ w_down


def rope_angles(seq_len):
    rows = seq_len // GRID_W
    t = jnp.arange(seq_len)
    row = (t // GRID_W - rows // 2).astype(F32)
    col = (t % GRID_W - GRID_W // 2).astype(F32)
    inv_freq = ROPE_THETA ** (-jnp.arange(0, ROPE_AXIS_DIM, 2, dtype=F32) / ROPE_AXIS_DIM)
    ang = jnp.concatenate([row[:, None] * inv_freq, col[:, None] * inv_freq], axis=-1)
    return jnp.cos(ang), jnp.sin(ang)


def apply_rope(x, cos, sin):
    xp = x.astype(F32).reshape(x.shape[:-1] + (HEAD_DIM // 2, 2))
    x0, x1 = xp[..., 0], xp[..., 1]
    c = cos[None, :, None, :]
    s = sin[None, :, None, :]
    out = jnp.stack([x0 * c - x1 * s, x0 * s + x1 * c], axis=-1)
    return out.reshape(x.shape).astype(x.dtype)


def attention_mixer(h, w_qkv, q_gain, k_gain, w_o, cos, sin):
    B, S, _ = h.shape
    qkv = h @ w_qkv
    q = qkv[..., :Q_DIM].reshape(B, S, N_HEADS, HEAD_DIM)
    k = qkv[..., Q_DIM:Q_DIM + KV_DIM].reshape(B, S, N_KV_HEADS, HEAD_DIM)
    v = qkv[..., Q_DIM + KV_DIM:].reshape(B, S, N_KV_HEADS, HEAD_DIM)
    q = apply_rope(rms_norm(q, q_gain), cos, sin)
    k = apply_rope(rms_norm(k, k_gain), cos, sin)
    nb = S // Q_BLOCK
    qb = q.reshape(B, nb, Q_BLOCK, N_KV_HEADS, GROUP, HEAD_DIM).transpose(1, 0, 2, 3, 4, 5)
    kf = k.astype(F32)
    vf = v.astype(F32)
    scale = HEAD_DIM ** -0.5

    def block(q_blk):
        s = jnp.einsum('bqkgd,bskd->bkgqs', q_blk.astype(F32), kf) * scale
        p = jax.nn.softmax(s, axis=-1)
        return jnp.einsum('bkgqs,bskd->bqkgd', p, vf).astype(h.dtype)

    o = lax.map(block, qb)
    o = o.transpose(1, 0, 2, 3, 4, 5).reshape(B, S, Q_DIM)
    return o @ w_o


def rwkv7_mixer(h, v_first, mix, w_rkv, w0, w1, w2, a0, a1, a2, g1, g2,
                k_k, k_a, r_k, ln_w, ln_b, w_o, vres):
    B, S, D = h.shape
    zero = jnp.zeros_like(h[:, :1])
    prev = jnp.concatenate([zero, h[:, :-1]], axis=1)
    nxt = jnp.concatenate([h[:, 1:], zero], axis=1)
    xx = 0.5 * (prev + nxt) - h
    xr, xw, xk, xv, xa, xg = (h + xx * mix[j] for j in range(6))
    r, k, v = jnp.einsum('nbsd,nde->nbse', jnp.stack([xr, xk, xv]), w_rkv)
    w_lora = jnp.einsum('nbsr,nrd->nbsd', jnp.tanh(jnp.einsum('bsd,ndr->nbsr', xw, w1)), w2)
    w_raw = -jax.nn.softplus(-(w0[:, None, None, :] + w_lora)) - 0.5
    decay = jnp.exp(-jnp.exp(w_raw.astype(F32)))
    a = jax.nn.sigmoid(a0[:, None, None, :]
                       + jnp.einsum('nbsr,nrd->nbsd', jnp.einsum('bsd,ndr->nbsr', xa, a1), a2))
    g = jax.nn.sigmoid(xg @ g1) @ g2
    kk = (k * k_k).reshape(B, S, RWKV_H, RWKV_N).astype(F32)
    kk = kk / jnp.maximum(jnp.sqrt(jnp.sum(kk * kk, axis=-1, keepdims=True)), 1e-12)
    k_dir = k[None] * (1 + (a - 1) * k_a)
    if vres is None:
        v_first = v
    else:
        v0, v1, v2 = vres
        v = v + (v_first - v) * jax.nn.sigmoid(v0 + (xv @ v1) @ v2)

    def heads(t):
        return t.reshape(t.shape[:-1] + (RWKV_H, RWKV_N))

    def dirs(t):
        return jnp.stack([t[0], jnp.flip(t[1], axis=1)])

    def shared(t):
        return jnp.stack([t, jnp.flip(t, axis=1)])

    xs = tuple(jnp.moveaxis(z.astype(F32), 2, 0) for z in (
        shared(heads(r)), dirs(heads(decay)), dirs(heads(k_dir)),
        shared(heads(v)), shared(kk), dirs(heads(a))))

    def step(state, inp):
        r_t, w_t, k_t, v_t, kk_t, a_t = inp
        sa = jnp.einsum('nbhvk,nbhk->nbhv', state, -kk_t)
        state = (state * w_t[..., None, :]
                 + sa[..., :, None] * (kk_t * a_t)[..., None, :]
                 + v_t[..., :, None] * k_t[..., None, :])
        return state, jnp.einsum('nbhvk,nbhk->nbhv', state, r_t)

    state0 = jnp.zeros((2, B, RWKV_H, RWKV_N, RWKV_N), F32)
    _, ys = lax.scan(step, state0, xs)
    ys = jnp.moveaxis(ys, 0, 2)
    y = ys[0] + jnp.flip(ys[1], axis=1)
    mu = jnp.mean(y, axis=-1, keepdims=True)
    var = jnp.mean((y - mu) ** 2, axis=-1, keepdims=True)
    y = ((y - mu) * lax.rsqrt(var + LNX_EPS)).reshape(B, S, D) * ln_w.astype(F32) + ln_b.astype(F32)
    bonus = jnp.sum(heads(r)[None] * heads(k_dir) * r_k, axis=-1, keepdims=True) * heads(v)[None]
    y = y + jnp.sum(bonus, axis=0).reshape(B, S, D).astype(F32)
    out = (y.astype(h.dtype) * g) @ w_o
    return out, v_first


def setup_inputs(seed: int = 0) -> dict:
    key = jax.random.key(seed)
    ks = iter(jax.random.split(key, 40))

    def nrm(shape, scale):
        return jax.random.normal(next(ks), shape, F32) * scale

    D = D_MODEL
    inp = {}
    inp['x'] = nrm((BATCH, SEQ, D), 1.0)
    inp['c'] = nrm((BATCH, D), 1.0)
    inp['w_mod'] = nrm((DEPTH, D, N_MOD * D), MOD_INIT * D ** -0.5)
    inp['b_mod'] = nrm((DEPTH, N_MOD * D), 0.01)
    inp['norm_g'] = 1.0 + nrm((DEPTH, 3, D), 0.02)
    inp['ffn_w_gate'] = nrm((DEPTH, 2, D, D_FF), D ** -0.5)
    inp['ffn_w_up'] = nrm((DEPTH, 2, D, D_FF), D ** -0.5)
    inp['ffn_w_down'] = nrm((DEPTH, 2, D_FF, D), D_FF ** -0.5)
    inp['attn_w_qkv'] = nrm((N_ATTN, D, Q_DIM + 2 * KV_DIM), D ** -0.5)
    inp['attn_q_gain'] = 1.0 + nrm((N_ATTN, HEAD_DIM), 0.02)
    inp['attn_k_gain'] = 1.0 + nrm((N_ATTN, HEAD_DIM), 0.02)
    inp['attn_w_o'] = nrm((N_ATTN, Q_DIM, D), Q_DIM ** -0.5)
    inp['rwkv_mix'] = jax.random.uniform(next(ks), (N_RWKV, 6, D), F32)
    inp['rwkv_w_rkv'] = nrm((N_RWKV, 3, D, D), D ** -0.5)
    inp['rwkv_w0'] = jax.random.uniform(next(ks), (N_RWKV, 2, D), F32, -6.0, 1.0)
    inp['rwkv_w1'] = nrm((N_RWKV, 2, D, DECAY_LORA), D ** -0.5)
    inp['rwkv_w2'] = nrm((N_RWKV, 2, DECAY_LORA, D), 0.1 * DECAY_LORA ** -0.5)
    inp['rwkv_a0'] = nrm((N_RWKV, 2, D), 0.1)
    inp['rwkv_a1'] = nrm((N_RWKV, 2, D, ICLR_LORA), D ** -0.5)
    inp['rwkv_a2'] = nrm((N_RWKV, 2, ICLR_LORA, D), 0.1 * ICLR_LORA ** -0.5)
    inp['rwkv_g1'] = nrm((N_RWKV, D, GATE_LORA), D ** -0.5)
    inp['rwkv_g2'] = nrm((N_RWKV, GATE_LORA, D), GATE_LORA ** -0.5)
    inp['rwkv_k_k'] = 0.85 + nrm((N_RWKV, D), 0.02)
    inp['rwkv_k_a'] = 1.0 + nrm((N_RWKV, D), 0.02)
    inp['rwkv_r_k'] = nrm((N_RWKV, RWKV_H, RWKV_N), 0.1)
    inp['rwkv_ln_w'] = 1.0 + nrm((N_RWKV, D), 0.02)
    inp['rwkv_ln_b'] = nrm((N_RWKV, D), 0.01)
    inp['rwkv_w_o'] = nrm((N_RWKV, D, D), D ** -0.5)
    inp['rwkv_v0'] = nrm((N_RWKV - 1, D), 0.1)
    inp['rwkv_v1'] = nrm((N_RWKV - 1, D, VRES_LORA), D ** -0.5)
    inp['rwkv_v2'] = nrm((N_RWKV - 1, VRES_LORA, D), 0.1 * VRES_LORA ** -0.5)
    inp['final_g'] = 1.0 + nrm((D,), 0.02)
    return inp


def reference(x, c, w_mod, b_mod, norm_g, ffn_w_gate, ffn_w_up, ffn_w_down,
              attn_w_qkv, attn_q_gain, attn_k_gain, attn_w_o,
              rwkv_mix, rwkv_w_rkv, rwkv_w0, rwkv_w1, rwkv_w2, rwkv_a0, rwkv_a1, rwkv_a2,
              rwkv_g1, rwkv_g2, rwkv_k_k, rwkv_k_a, rwkv_r_k, rwkv_ln_w, rwkv_ln_b, rwkv_w_o,
              rwkv_v0, rwkv_v1, rwkv_v2, final_g):
    B, S, D = x.shape
    cos, sin = rope_angles(S)
    cs = jax.nn.silu(c)
    v_first = None
    for i in range(DEPTH):
        mod = (cs @ w_mod[i] + b_mod[i]).reshape(B, N_MOD, D)
        sh1, sc1, gt1, shm, scm, gtm, sh2, sc2, gt2 = [mod[:, j] for j in range(N_MOD)]
        h = ada_norm(x, norm_g[i, 0], sh1, sc1)
        x = x + FFN_RES * gt1[:, None, :] * swiglu(h, ffn_w_gate[i, 0], ffn_w_up[i, 0], ffn_w_down[i, 0])
        h = ada_norm(x, norm_g[i, 1], shm, scm)
        j = i // N_MIXERS
        if i % N_MIXERS == 0:
            m = attention_mixer(h, attn_w_qkv[j], attn_q_gain[j], attn_k_gain[j], attn_w_o[j], cos, sin)
        else:
            vres = None if j == 0 else (rwkv_v0[j - 1], rwkv_v1[j - 1], rwkv_v2[j - 1])
            m, v_first = rwkv7_mixer(h, v_first, rwkv_mix[j], rwkv_w_rkv[j], rwkv_w0[j], rwkv_w1[j],
                                     rwkv_w2[j], rwkv_a0[j], rwkv_a1[j], rwkv_a2[j], rwkv_g1[j],
                                     rwkv_g2[j], rwkv_k_k[j], rwkv_k_a[j], rwkv_r_k[j], rwkv_ln_w[j],
                                     rwkv_ln_b[j], rwkv_w_o[j], vres)
        x = x + gtm[:, None, :] * m
        h = ada_norm(x, norm_g[i, 2], sh2, sc2)
        x = x + FFN_RES * gt2[:, None, :] * swiglu(h, ffn_w_gate[i, 1], ffn_w_up[i, 1], ffn_w_down[i, 1])
    return rms_norm(x, final_g)
```

```cpp
#include <hip/hip_runtime.h>
#include <hip/hip_cooperative_groups.h>
#include <hip/hip_bf16.h>
#include <cstdio>
#include <cstdint>
namespace cg = cooperative_groups;
__device__ __forceinline__ int mk_tid() { int t = threadIdx.x; asm volatile("" : "+v"(t)); return t; }
namespace pg8 {
#define PG8_LAS __attribute__((address_space(3)))
typedef unsigned short bf16_t;
typedef short bf16x8 __attribute__((ext_vector_type(8)));
typedef float f32x4 __attribute__((ext_vector_type(4)));
typedef unsigned u32x4 __attribute__((ext_vector_type(4)));
constexpr int BM = 256, BK = 64, HALF = 128, HTB = HALF * BK * 2  , STAGE_BYTES = 8 * HTB, NXCD = 8, WGM = 8;

__host__ __device__ __forceinline__ int lds_byte(int r, int c) { const int st = (r >> 4) * 2 + (c >> 5), rr = r & 15, cc = c & 31, ob = rr * 64 + cc * 2; return st * 1024 + (ob ^ (((ob >> 9) & 1) << 5)); }
__host__ __device__ __forceinline__ void stage_rc(int b, int& R, int& C) { const int st = b / 1024, sb = b % 1024, swz = sb ^ (((sb >> 9) & 1) << 5); R = (st >> 1) * 16 + swz / 64; C = (st & 1) * 32 + (swz % 64) / 2; }
__host__ __device__ __forceinline__ int perm32(int rho) { const int n = rho >> 4, i = rho & 15; return 8 * (i >> 2) + 4 * n + (i & 3); }

struct Unit { int pm, pn; };
struct Gemm { const bf16_t* A; const bf16_t* Bt; int M, N, K; };

struct StaticOrder {
    int nM, nN, nwg, G, c;
    __host__ __device__ void init(int M, int N, int G_, int c_) { nM = M / BM; nN = N / BM; nwg = nM * nN; G = G_; c = c_; }
    __host__ __device__ bool next(int i, Unit& u) const {
        const long L = (long)i * G + c; if (L >= nwg) return false;
        int wgid = (int)L; { const int q = nwg / NXCD, r = nwg % NXCD, xcd = wgid % NXCD, off = wgid / NXCD; wgid = (xcd < r ? xcd * (q + 1) : r * (q + 1) + (xcd - r) * q) + off; }
        const int nig = WGM * nN, gid = wgid / nig, fm = gid * WGM, gsz = (nM - fm) < WGM ? (nM - fm) : WGM;
        u.pm = fm + ((wgid % nig) % gsz); u.pn = (wgid % nig) / gsz; return true;
    }
    __device__ __forceinline__ void a_ready(const Unit&) const {}
    __device__ __forceinline__ void done(const Unit&) const {}
};

__device__ __forceinline__ unsigned cvt_pk_bf16(float lo, float hi) { unsigned r; asm volatile("v_cvt_pk_bf16_f32 %0, %1, %2" : "=v"(r) : "v"(lo), "v"(hi)); return r; }
typedef float f32x2 __attribute__((ext_vector_type(2)));
typedef unsigned u32x2 __attribute__((ext_vector_type(2)));

struct GenOrder {
    StaticOrder so; int single, pm, pn;
    __device__ bool next(int i, Unit& u) const { if (single) { if (i != 0 || pm < 0) return false; u.pm = pm; u.pn = pn; return true; } return so.next(i, u); }
    __device__ __forceinline__ void a_ready(const Unit&) const {}
    __device__ __forceinline__ void done(const Unit&) const {}
};

__device__ __forceinline__ float fsigmoid(float z) { return __builtin_amdgcn_rcpf(1.0f + __builtin_amdgcn_exp2f(-1.4426950408889634f * z)); }
__device__ __forceinline__ float act_apply(float z, int act) {
    if (act == 1) return 1.0f - 2.0f * __builtin_amdgcn_rcpf(1.0f + __builtin_amdgcn_exp2f(2.8853900817779268f * z));
    if (act == 2) return fsigmoid(z);
    if (act == 3) return __builtin_amdgcn_exp2f(-0.8750387749145276f * fsigmoid(z));
    return z;
}

struct EpiBf16Out {
    static constexpr bool PERM = true, AFTER_DRAIN = false;
    bf16_t* O; int ldc; const float* bias; int act; int nvalid;
    __device__ __forceinline__ void operator()(const f32x4 (&acc)[2][2][4][2], const Unit& u, int, int, int, int) const {
        const int t2 = mk_tid(), wr = t2 >> 8, wc = (t2 >> 6) & 3, fr = t2 & 15, fq = (t2 >> 4) & 3;
        const int row0 = u.pm * BM + wr * 64 + fr;
#pragma unroll
        for (int bj = 0; bj < 2; ++bj) {
            const int colb = u.pn * BM + bj * HALF + wc * 32 + 8 * fq;
            if (colb >= nvalid) continue;
            f32x4 b0 = (f32x4){0.f, 0.f, 0.f, 0.f}, b1 = b0;
            if (bias) { b0 = *(const f32x4*)(bias + colb); b1 = *(const f32x4*)(bias + colb + 4); }
#pragma unroll
            for (int ai = 0; ai < 2; ++ai)
#pragma unroll
                for (int m = 0; m < 4; ++m) {
                    f32x4 v0 = acc[ai][bj][m][0] + b0, v1 = acc[ai][bj][m][1] + b1;
                    if (act != 0) {
#pragma unroll
                        for (int e = 0; e < 4; ++e) { v0[e] = act_apply(v0[e], act); v1[e] = act_apply(v1[e], act); }
                    }
                    u32x4 w; w.x = cvt_pk_bf16(v0[0], v0[1]); w.y = cvt_pk_bf16(v0[2], v0[3]); w.z = cvt_pk_bf16(v1[0], v1[1]); w.w = cvt_pk_bf16(v1[2], v1[3]);
                    *(u32x4*)(O + (size_t)(row0 + ai * HALF + m * 16) * ldc + colb) = w;
                }
        }
    }
};
struct EpiF32Out {
    static constexpr bool PERM = false, AFTER_DRAIN = false;
    float* O; int ldc; const float* bias; int act;
    __device__ __forceinline__ void operator()(const f32x4 (&acc)[2][2][4][2], const Unit& u, int, int, int, int) const {
        const int t2 = mk_tid(), wr = t2 >> 8, wc = (t2 >> 6) & 3, fr = t2 & 15, fq = (t2 >> 4) & 3;
        const int row0 = u.pm * BM + wr * 64 + fr;
#pragma unroll
        for (int bj = 0; bj < 2; ++bj)
#pragma unroll
            for (int n = 0; n < 2; ++n) {
                const int col = u.pn * BM + bj * HALF + wc * 32 + 16 * n + 4 * fq;
                f32x4 b0 = (f32x4){0.f, 0.f, 0.f, 0.f};
                if (bias) b0 = *(const f32x4*)(bias + col);
#pragma unroll
                for (int ai = 0; ai < 2; ++ai)
#pragma unroll
                    for (int m = 0; m < 4; ++m) {
                        f32x4 v = acc[ai][bj][m][n] + b0;
#pragma unroll
                        for (int e = 0; e < 4; ++e) v[e] = __builtin_amdgcn_exp2f(-0.8750387749145276f * fsigmoid(v[e]));
                        *(f32x4*)(O + (size_t)(row0 + ai * HALF + m * 16) * ldc + col) = v;
                    }
            }
    }
};
struct EpiResid {
    static constexpr bool PERM = false, AFTER_DRAIN = false;
    const float* base; float* out; const float* gate; int gstride; float coef;
    __device__ __forceinline__ void operator()(const f32x4 (&acc)[2][2][4][2], const Unit& u, int, int, int, int) const {
        const int t2 = mk_tid(), wr = t2 >> 8, wc = (t2 >> 6) & 3, fr = t2 & 15, fq = (t2 >> 4) & 3;
        const int row0 = u.pm * BM + wr * 64 + fr;
        const float* gb = gate + (size_t)((u.pm * BM) >> 13) * gstride;
#pragma unroll
        for (int bj = 0; bj < 2; ++bj)
#pragma unroll
            for (int n = 0; n < 2; ++n) {
                const int col = u.pn * BM + bj * HALF + wc * 32 + 16 * n + 4 * fq;
                const f32x4 gv = *(const f32x4*)(gb + col) * coef;
#pragma unroll
                for (int ai = 0; ai < 2; ++ai)
#pragma unroll
                    for (int m = 0; m < 4; ++m) {
                        const size_t off = (size_t)(row0 + ai * HALF + m * 16) * 1024 + col;
                        const f32x4 bs = *(const f32x4*)(base + off);
                        *(f32x4*)(out + off) = bs + gv * acc[ai][bj][m][n];
                    }
            }
    }
};
struct EpiSwiglu {
    static constexpr bool PERM = true, AFTER_DRAIN = false;
    bf16_t* O; int ldc;
    __device__ __forceinline__ void operator()(const f32x4 (&acc)[2][2][4][2], const Unit& u, int, int, int, int) const {
        const int t2 = mk_tid(), wr = t2 >> 8, wc = (t2 >> 6) & 3, fr = t2 & 15, fq = (t2 >> 4) & 3;
        const int row0 = u.pm * BM + wr * 64 + fr;
        const int colb = u.pn * HALF + wc * 32 + 8 * fq;
#pragma unroll
        for (int ai = 0; ai < 2; ++ai)
#pragma unroll
            for (int m = 0; m < 4; ++m) {
                f32x4 g0 = acc[ai][0][m][0], g1 = acc[ai][0][m][1];
                const f32x4 u0 = acc[ai][1][m][0], u1 = acc[ai][1][m][1];
#pragma unroll
                for (int e = 0; e < 4; ++e) { g0[e] = g0[e] * fsigmoid(g0[e]) * u0[e]; g1[e] = g1[e] * fsigmoid(g1[e]) * u1[e]; }
                u32x4 w; w.x = cvt_pk_bf16(g0[0], g0[1]); w.y = cvt_pk_bf16(g0[2], g0[3]); w.z = cvt_pk_bf16(g1[0], g1[1]); w.w = cvt_pk_bf16(g1[2], g1[3]);
                *(u32x4*)(O + (size_t)(row0 + ai * HALF + m * 16) * ldc + colb) = w;
            }
    }
};

template <class Epi, class Sched, bool ALIGN_EPI = false, bool SP2 = false>
__device__ __forceinline__ void gemm_phase(PG8_LAS unsigned char* lds, const Gemm g, const Sched& S, const Epi& E) {
    const int tid = mk_tid(), wid = __builtin_amdgcn_readfirstlane(tid >> 6), lane = tid & 63, wr = wid >> 2, wc = wid & 3, fr = lane & 15, fq = lane >> 4;
    const int K = g.K, nt = K / BK;
    unsigned voffA[2], voffB[2];
#pragma unroll
    for (int i = 0; i < 2; ++i) { int R, C; stage_rc(tid * 16 + i * 8192, R, C); const int Rb = Epi::PERM ? ((R & ~31) + perm32(R & 31)) : R;
        voffA[i] = (unsigned)(R * K + C) * 2u; voffB[i] = (unsigned)(Rb * K + C) * 2u; }
    const size_t kstep = (size_t)(BK * 2);
    const size_t hstep = (size_t)HALF * K * 2;
    const size_t tstep = 2 * hstep;
    const unsigned ldsw = (unsigned)wid * 1024u;
    const int aoff = lds_byte(wr * 64 + fr, fq * 8), boff = lds_byte(wc * 32 + fr, fq * 8);
#define PG8_SA(b, h) (((b) * 2 + (h)) * HTB)
#define PG8_SB(b, h) ((4 + (b) * 2 + (h)) * HTB)
#define PG8_STAGE(bufoff, gbase, voff) do { _Pragma("unroll") for (int _i = 0; _i < 2; ++_i) \
        __builtin_amdgcn_global_load_lds((const unsigned*)((const char*)(gbase) + (voff)[_i]), (PG8_LAS unsigned*)(lds + (bufoff) + ldsw + _i * 8192), 16, 0, 0); } while (0)
#define PG8_LDA(dst, b, h) do { _Pragma("unroll") for (int m = 0; m < 4; ++m) _Pragma("unroll") for (int k = 0; k < 2; ++k) dst[m][k] = *(const PG8_LAS bf16x8*)(lds + PG8_SA(b, h) + aoff + m * 2048 + k * 1024); } while (0)
#define PG8_LDB(dst, b, h) do { _Pragma("unroll") for (int n = 0; n < 2; ++n) _Pragma("unroll") for (int k = 0; k < 2; ++k) dst[n][k] = *(const PG8_LAS bf16x8*)(lds + PG8_SB(b, h) + boff + n * 2048 + k * 1024); } while (0)
#define PG8_MMA(ai, bj, At, Bt) do { __builtin_amdgcn_s_setprio(1); _Pragma("unroll") for (int m = 0; m < 4; ++m) _Pragma("unroll") for (int n = 0; n < 2; ++n) _Pragma("unroll") for (int k = 0; k < 2; ++k) \
        acc[ai][bj][m][n] = __builtin_amdgcn_mfma_f32_16x16x32_bf16(Bt[n][k], At[m][k], acc[ai][bj][m][n], 0, 0, 0); __builtin_amdgcn_s_setprio(0); } while (0)
#define PG8_WAIT_V(n) asm volatile("s_waitcnt vmcnt(" #n ")" ::: "memory")
#define PG8_WAIT_L(n) asm volatile("s_waitcnt lgkmcnt(" #n ")" ::: "memory")
#define PG8_BAR __builtin_amdgcn_s_barrier()
#define PG8_SCHED __builtin_amdgcn_sched_barrier(0)
    Unit cur, nxt; int ui = 0;
    if (!S.next(0, cur)) return;
    f32x4 acc[2][2][4][2];
#pragma unroll
    for (int a = 0; a < 2; ++a)
#pragma unroll
        for (int b = 0; b < 2; ++b)
#pragma unroll
            for (int m = 0; m < 4; ++m)
#pragma unroll
                for (int n = 0; n < 2; ++n) acc[a][b][m][n] = (f32x4){0.f, 0.f, 0.f, 0.f};
    bf16x8 At[4][2], B0[2][2], B1[2][2];
    const char* cA = (const char*)g.A + (size_t)cur.pm * tstep; const char* cB = (const char*)g.Bt + (size_t)cur.pn * tstep;
    S.a_ready(cur);
    if constexpr (SP2) {
        PG8_STAGE(PG8_SB(0, 0), cB, voffB); PG8_STAGE(PG8_SB(0, 1), cB + hstep, voffB); PG8_STAGE(PG8_SA(0, 0), cA, voffA); PG8_STAGE(PG8_SA(0, 1), cA + hstep, voffA);
        if (wr == 1) PG8_BAR;
        PG8_WAIT_V(2); PG8_BAR;
        PG8_STAGE(PG8_SB(1, 0), cB + kstep, voffB); PG8_STAGE(PG8_SA(1, 0), cA + kstep, voffA); PG8_STAGE(PG8_SB(1, 1), cB + hstep + kstep, voffB);
        PG8_WAIT_V(6); PG8_BAR;
    } else {
        PG8_STAGE(PG8_SB(0, 0), cB, voffB); PG8_STAGE(PG8_SA(0, 0), cA, voffA); PG8_STAGE(PG8_SB(0, 1), cB + hstep, voffB); PG8_STAGE(PG8_SA(0, 1), cA + hstep, voffA);
        if (wr == 1) PG8_BAR;
        PG8_WAIT_V(4); PG8_BAR;
        PG8_STAGE(PG8_SB(1, 0), cB + kstep, voffB); PG8_STAGE(PG8_SA(1, 0), cA + kstep, voffA); PG8_STAGE(PG8_SB(1, 1), cB + hstep + kstep, voffB);
        PG8_WAIT_V(6); PG8_BAR;
    }
    for (;;) {
        const bool has_next = S.next(ui + 1, nxt);
        const char* nA = has_next ? (const char*)g.A + (size_t)nxt.pm * tstep : cA; const char* nB = has_next ? (const char*)g.Bt + (size_t)nxt.pn * tstep : cB;
        for (int t = 0; t < nt; t += 2) {
            const bool last = (t == nt - 2);
            const char* a1 = cA + (size_t)(t + 1) * kstep;
            const char* a2 = last ? nA : cA + (size_t)(t + 2) * kstep; const char* b2 = last ? nB : cB + (size_t)(t + 2) * kstep;
            const char* a3 = a2 + kstep; const char* b3 = b2 + kstep;
            if (last && has_next) S.a_ready(nxt);
            if constexpr (SP2) {
            PG8_LDB(B0, 0, 0); PG8_LDB(B1, 0, 1); PG8_SCHED; PG8_LDA(At, 0, 0); PG8_STAGE(PG8_SA(1, 1), a1 + hstep, voffA);
            PG8_WAIT_V(8); PG8_WAIT_L(0); PG8_BAR; PG8_MMA(0, 0, At, B0); PG8_MMA(0, 1, At, B1); PG8_BAR; PG8_SCHED;
            PG8_LDA(At, 0, 1); PG8_STAGE(PG8_SB(0, 0), b2, voffB); PG8_STAGE(PG8_SB(0, 1), b2 + hstep, voffB); PG8_STAGE(PG8_SA(0, 0), a2, voffA);
            PG8_WAIT_V(8); PG8_WAIT_L(0); PG8_BAR; PG8_MMA(1, 0, At, B0); PG8_MMA(1, 1, At, B1); PG8_BAR; PG8_SCHED;
            PG8_LDB(B0, 1, 0); PG8_LDB(B1, 1, 1); PG8_SCHED; PG8_LDA(At, 1, 0); PG8_STAGE(PG8_SA(0, 1), a2 + hstep, voffA);
            PG8_WAIT_V(8); PG8_WAIT_L(0); PG8_BAR; PG8_MMA(0, 0, At, B0); PG8_MMA(0, 1, At, B1); PG8_BAR; PG8_SCHED;
            PG8_LDA(At, 1, 1); PG8_STAGE(PG8_SB(1, 0), b3, voffB); PG8_STAGE(PG8_SB(1, 1), b3 + hstep, voffB); PG8_STAGE(PG8_SA(1, 0), a3, voffA);
            PG8_WAIT_V(8); PG8_WAIT_L(0); PG8_BAR; PG8_MMA(1, 0, At, B0); PG8_MMA(1, 1, At, B1); PG8_BAR; PG8_SCHED;
            } else {
            PG8_LDB(B0, 0, 0); PG8_SCHED; PG8_LDA(At, 0, 0); PG8_STAGE(PG8_SA(1, 1), a1 + hstep, voffA);
            PG8_WAIT_L(8); PG8_BAR; PG8_WAIT_L(0); PG8_MMA(0, 0, At, B0); PG8_BAR; PG8_SCHED;
            PG8_LDB(B1, 0, 1); PG8_STAGE(PG8_SB(0, 0), b2, voffB);
            PG8_BAR; PG8_WAIT_L(0); PG8_MMA(0, 1, At, B1); PG8_BAR;
            PG8_LDA(At, 0, 1); PG8_STAGE(PG8_SA(0, 0), a2, voffA);
            PG8_BAR; PG8_WAIT_L(0); PG8_MMA(1, 0, At, B0); PG8_BAR; PG8_SCHED;
            PG8_STAGE(PG8_SB(0, 1), b2 + hstep, voffB);
            PG8_WAIT_V(6); PG8_BAR; PG8_MMA(1, 1, At, B1); PG8_BAR;
            PG8_LDB(B0, 1, 0); PG8_SCHED; PG8_LDA(At, 1, 0); PG8_STAGE(PG8_SA(0, 1), a2 + hstep, voffA);
            PG8_WAIT_L(8); PG8_BAR; PG8_WAIT_L(0); PG8_MMA(0, 0, At, B0); PG8_BAR; PG8_SCHED;
            PG8_LDB(B1, 1, 1); PG8_STAGE(PG8_SB(1, 0), b3, voffB);
            PG8_BAR; PG8_WAIT_L(0); PG8_MMA(0, 1, At, B1); PG8_BAR;
            PG8_LDA(At, 1, 1); PG8_STAGE(PG8_SA(1, 0), a3, voffA);
            PG8_BAR; PG8_WAIT_L(0); PG8_MMA(1, 0, At, B0); PG8_BAR; PG8_SCHED;
            PG8_STAGE(PG8_SB(1, 1), b3 + hstep, voffB);
            PG8_WAIT_V(6); PG8_BAR; PG8_MMA(1, 1, At, B1); PG8_BAR;
            }
        }
        if constexpr (ALIGN_EPI) { if (wr == 0) PG8_BAR; }
        if constexpr (!Epi::AFTER_DRAIN) { E(acc, cur, wr, wc, fr, fq); S.done(cur); }
        if (!has_next) break;
#pragma unroll
        for (int a = 0; a < 2; ++a)
#pragma unroll
            for (int b = 0; b < 2; ++b)
#pragma unroll
                for (int m = 0; m < 4; ++m)
#pragma unroll
                    for (int n = 0; n < 2; ++n) acc[a][b][m][n] = (f32x4){0.f, 0.f, 0.f, 0.f};
        cur = nxt; cA = nA; cB = nB; ++ui;
        if constexpr (ALIGN_EPI) { if (wr == 1) PG8_BAR; }
    }
    PG8_WAIT_V(0);
    if constexpr (!ALIGN_EPI) { if (wr == 0) PG8_BAR; }
    PG8_BAR;
    if constexpr (Epi::AFTER_DRAIN) { E.fused(acc, cur, wr, wc, fr, fq, lds, wid, lane); S.done(cur); }
#undef PG8_SA
#undef PG8_SB
#undef PG8_STAGE
#undef PG8_LDA
#undef PG8_LDB
#undef PG8_MMA
#undef PG8_WAIT_V
#undef PG8_WAIT_L
#undef PG8_BAR
#undef PG8_SCHED
}
}

namespace att {
using bf16 = __hip_bfloat16;
constexpr int   D = 128, NW = 8, QBLK = 32, KVBLK = 64;
constexpr float SCALE = 0.088388347648318440f;
constexpr float THR = 8.f;
constexpr int SDEPTH = 2;
constexpr int LDQ = 1536, LDK = 1536, LDO = 1024;
constexpr size_t SHM_V = KVBLK * D * 2, SHM_K = KVBLK * D * 2, SHM_ATTN = 2 * SHM_V + 2 * SHM_K + NW * 64 * 4;
using bf16x8 = __attribute__((ext_vector_type(8))) short;
using s16x4  = __attribute__((ext_vector_type(4))) short;
using f32x16 = __attribute__((ext_vector_type(16))) float;
using f32x8  = __attribute__((ext_vector_type(8))) float;
using u32x4  = __attribute__((ext_vector_type(4))) unsigned;
#define KSWZ(row, colB) ((row) * 256 + ((colB) ^ (((row) & 7) << 4)))
#define SBAR() __builtin_amdgcn_sched_barrier(0)
__device__ __forceinline__ int crow(int r, int hi) { return (r & 3) + 8 * (r >> 2) + 4 * hi; }
__device__ __forceinline__ unsigned cvtpk(float lo, float hi) {
  unsigned r; asm volatile("v_cvt_pk_bf16_f32 %0, %1, %2" : "=v"(r) : "v"(lo), "v"(hi)); return r;
}
template <typename TIn> struct Stage;
template <> struct Stage<bf16>  { using T = bf16x8;
  __device__ static __forceinline__ T ld8(const bf16* p) { return *reinterpret_cast<const bf16x8*>(p); }
  __device__ static __forceinline__ bf16x8 tobf(T x) { return x; } };
template <> struct Stage<float> { using T = f32x8;
  __device__ static __forceinline__ T ld8(const float* p) { return *reinterpret_cast<const f32x8*>(p); }
  __device__ static __forceinline__ bf16x8 tobf(T x) {
    u32x4 w = {cvtpk(x[0], x[1]), cvtpk(x[2], x[3]), cvtpk(x[4], x[5]), cvtpk(x[6], x[7])}; return *reinterpret_cast<bf16x8*>(&w); } };

__device__ __forceinline__ void partialSM(f32x16& p0, f32x16& p1, float& m_reg, float& mn, float& alpha) {
  constexpr float C = SCALE * 1.4426950408889634f;
  float pmax = p0[0]; for (int r = 1; r < 16; ++r) pmax = fmaxf(pmax, p0[r]); for (int r = 0; r < 16; ++r) pmax = fmaxf(pmax, p1[r]);
  { auto rr = __builtin_amdgcn_permlane32_swap(__float_as_uint(pmax), __float_as_uint(pmax), false, false);
    pmax = fmaxf(__uint_as_float(rr[0]), __uint_as_float(rr[1])); }
  if (__builtin_expect(__all(pmax - m_reg <= THR / SCALE), 1)) { mn = m_reg; alpha = 1.f; }
  else { mn = fmaxf(m_reg, pmax); alpha = __builtin_amdgcn_exp2f((m_reg - mn) * C); m_reg = mn; }
  float mnC = -mn * C;
  for (int r = 0; r < 16; ++r) p0[r] = fmaf(p0[r], C, mnC); for (int r = 0; r < 16; ++r) p1[r] = fmaf(p1[r], C, mnC);
  for (int r = 0; r < 16; ++r) p0[r] = __builtin_amdgcn_exp2f(p0[r]);
}
__device__ __forceinline__ void finishSM(f32x16& p0, f32x16& p1, float alpha, float& l_reg, bf16x8& pa0, bf16x8& pa1, bf16x8& pa2, bf16x8& pa3) {
  for (int r = 0; r < 16; ++r) p1[r] = __builtin_amdgcn_exp2f(p1[r]);
  float ps = 0; for (int r = 0; r < 16; ++r) ps += p0[r]; for (int r = 0; r < 16; ++r) ps += p1[r];
  { auto rr = __builtin_amdgcn_permlane32_swap(__float_as_uint(ps), __float_as_uint(ps), false, false);
    ps = __uint_as_float(rr[0]) + __uint_as_float(rr[1]); }
  l_reg = l_reg * alpha + ps;
#define PK4(P, BASE, OUT) do { unsigned a0 = cvtpk(P[BASE + 0], P[BASE + 1]), a1 = cvtpk(P[BASE + 2], P[BASE + 3]);   \
    unsigned b0 = cvtpk(P[BASE + 4], P[BASE + 5]), b1 = cvtpk(P[BASE + 6], P[BASE + 7]);                              \
    auto r0 = __builtin_amdgcn_permlane32_swap(a0, b0, false, false); auto r1 = __builtin_amdgcn_permlane32_swap(a1, b1, false, false); \
    u32x4 w = {r0[0], r1[0], r0[1], r1[1]}; OUT = *reinterpret_cast<bf16x8*>(&w); } while (0)
  PK4(p0, 0, pa0); PK4(p0, 8, pa1); PK4(p1, 0, pa2); PK4(p1, 8, pa3);
#undef PK4
}
__device__ __forceinline__ void qkt(f32x16& p0, f32x16& p1, const bf16* Ks, const bf16x8* qr, int r32, int hi) {
  p0 = f32x16{}; p1 = f32x16{};
  for (int d0 = 0; d0 < 8; ++d0) { int cb = (d0 * 16 + hi * 8) * 2;
    bf16x8 b0 = *reinterpret_cast<const bf16x8*>((const char*)Ks + KSWZ(r32, cb));
    bf16x8 b1 = *reinterpret_cast<const bf16x8*>((const char*)Ks + KSWZ(32 + r32, cb));
    p0 = __builtin_amdgcn_mfma_f32_32x32x16_bf16(b0, qr[d0], p0, 0, 0, 0);
    p1 = __builtin_amdgcn_mfma_f32_32x32x16_bf16(b1, qr[d0], p1, 0, 0, 0); }
}
__device__ __forceinline__ int v_st(int k, int c) { const int kk = (k & ~0xC) | ((k & 4) << 1) | ((k & 8) >> 1); return ((kk >> 3) * 4 + (c >> 5)) * 512 + ((kk & 7) * 32 + (c & 31)) * 2; }
__device__ __forceinline__ int v_rd_base(int lane) { return ((lane & 3) << 3) | (((lane >> 2) & 3) << 6) | (((lane >> 4) & 1) << 5) | (((lane >> 5) & 1) << 8); }
constexpr int v_rd_off(int d0, int ks, int half) { return d0 * 512 + ks * 4096 + half * 2048; }
template <int OFF> __device__ __forceinline__ s16x4 tr_read(int vb) {
  s16x4 r; asm volatile("ds_read_b64_tr_b16 %0, %1 offset:%2" : "=&v"(r) : "v"(vb), "i"(OFF) : "memory"); return r;
}
template <int D0> __device__ __forceinline__ void pv_one(f32x16& od, int vb, bf16x8 pa0, bf16x8 pa1, bf16x8 pa2, bf16x8 pa3) {
  const s16x4 l0 = tr_read<v_rd_off(D0, 0, 0)>(vb), h0 = tr_read<v_rd_off(D0, 0, 1)>(vb), l1 = tr_read<v_rd_off(D0, 1, 0)>(vb), h1 = tr_read<v_rd_off(D0, 1, 1)>(vb);
  const s16x4 l2 = tr_read<v_rd_off(D0, 2, 0)>(vb), h2 = tr_read<v_rd_off(D0, 2, 1)>(vb), l3 = tr_read<v_rd_off(D0, 3, 0)>(vb), h3 = tr_read<v_rd_off(D0, 3, 1)>(vb);
  asm volatile("s_waitcnt lgkmcnt(0)" ::: "memory"); SBAR();
#define PK(L, H) (bf16x8){L[0], L[1], L[2], L[3], H[0], H[1], H[2], H[3]}
  od = __builtin_amdgcn_mfma_f32_32x32x16_bf16(pa0, PK(l0, h0), od, 0, 0, 0);
  od = __builtin_amdgcn_mfma_f32_32x32x16_bf16(pa1, PK(l1, h1), od, 0, 0, 0);
  od = __builtin_amdgcn_mfma_f32_32x32x16_bf16(pa2, PK(l2, h2), od, 0, 0, 0);
  od = __builtin_amdgcn_mfma_f32_32x32x16_bf16(pa3, PK(l3, h3), od, 0, 0, 0);
#undef PK
}
__device__ __forceinline__ void pv_d0(f32x16* o, int vb, bf16x8 pa0, bf16x8 pa1, bf16x8 pa2, bf16x8 pa3) {
  pv_one<0>(o[0], vb, pa0, pa1, pa2, pa3); pv_one<1>(o[1], vb, pa0, pa1, pa2, pa3); pv_one<2>(o[2], vb, pa0, pa1, pa2, pa3); pv_one<3>(o[3], vb, pa0, pa1, pa2, pa3);
}

template <typename TQ>
__device__ __forceinline__ void attn_dense_body(const TQ* __restrict__ Qb, const bf16* __restrict__ Kh, const bf16* __restrict__ Vh,
                                                bf16* __restrict__ Ob, int seq, char* lds) {
  using St = Stage<bf16>; using SQ = Stage<TQ>;
  const int tid = mk_tid(), wid = tid >> 6, lane = tid & 63, r32 = lane & 31, hi = lane >> 5;
  bf16* V_lds = (bf16*)lds; bf16* K_lds = (bf16*)(lds + 2 * SHM_V);
  float* ws = (float*)(lds + 2 * SHM_V + 2 * SHM_K) + wid * 64; float* li_l = ws; float* al_l = ws + 32;
  float m_reg = -1e30f, l_reg = 0; f32x16 o[4] = {}; bf16x8 qr[8];
  const TQ* Qw = Qb + (long)(wid * QBLK + r32) * LDQ + hi * 8;
#pragma unroll
  for (int d0 = 0; d0 < 8; ++d0) qr[d0] = SQ::tobf(SQ::ld8(Qw + d0 * 16));
  const int sr = tid >> 4, sc = (tid & 15) * 8, vst0 = v_st(sr, sc), vst1 = v_st(32 + sr, sc);
  const int vb0 = (int)(uintptr_t)V_lds + v_rd_base(lane);
  struct { typename St::T vs0, vs1, ks0, ks1; } sr_[SDEPTH];
#define SLOAD(i, k0) do { sr_[i].vs0 = St::ld8(&Vh[(long)((k0) + sr) * LDK + sc]); sr_[i].vs1 = St::ld8(&Vh[(long)((k0) + 32 + sr) * LDK + sc]); \
    sr_[i].ks0 = St::ld8(&Kh[(long)((k0) + sr) * LDK + sc]); sr_[i].ks1 = St::ld8(&Kh[(long)((k0) + 32 + sr) * LDK + sc]); } while (0)
#define SWRITE(b, i) do { *(bf16x8*)((char*)V_lds + (b) * SHM_V + vst0) = St::tobf(sr_[i].vs0);          \
    *(bf16x8*)((char*)V_lds + (b) * SHM_V + vst1) = St::tobf(sr_[i].vs1); int kc = sc * 2;               \
    *(bf16x8*)((char*)K_lds + (b) * SHM_K + KSWZ(sr, kc)) = St::tobf(sr_[i].ks0);                       \
    *(bf16x8*)((char*)K_lds + (b) * SHM_K + KSWZ(32 + sr, kc)) = St::tobf(sr_[i].ks1); } while (0)
#define SWAIT() do { if constexpr (SDEPTH == 2) asm volatile("s_waitcnt vmcnt(4)" ::: "memory"); else asm volatile("s_waitcnt vmcnt(0)" ::: "memory"); } while (0)
#define RESC(a) do { if (__any((a) < 1.f)) { if (hi == 0) al_l[r32] = (a); asm volatile("s_waitcnt lgkmcnt(0)" ::: "memory"); \
    for (int d = 0; d < 4; ++d) for (int r = 0; r < 16; ++r) o[d][r] *= al_l[crow(r, hi)]; } } while (0)
  f32x16 pA0, pA1, pB0, pB1; float mnA, mnB, alA, alB; bf16x8 pa0, pa1, pa2, pa3; const int NT = seq / KVBLK;
  constexpr int SE = 0, SO = SDEPTH - 1;
  SLOAD(SE, 0); asm volatile("s_waitcnt vmcnt(0)" ::: "memory"); SWRITE(0, SE); __syncthreads();
  qkt(pA0, pA1, K_lds, qr, r32, hi); partialSM(pA0, pA1, m_reg, mnA, alA);
  SLOAD(SO, KVBLK); if constexpr (SDEPTH == 2) { if (2 < NT) SLOAD(SE, 2 * KVBLK); }
  SWAIT(); SWRITE(1, SO); __syncthreads();
  for (int j = 1; j + 1 < NT; j += 2) {
    SBAR(); qkt(pB0, pB1, (bf16*)((char*)K_lds + SHM_K), qr, r32, hi);
    finishSM(pA0, pA1, alA, l_reg, pa0, pa1, pa2, pa3); SBAR();
    SLOAD(SO, (j + SDEPTH) * KVBLK); SBAR();
    pv_d0(o, vb0, pa0, pa1, pa2, pa3); partialSM(pB0, pB1, m_reg, mnB, alB);
    __syncthreads(); SWAIT(); SWRITE(0, SE);
    RESC(alB); __syncthreads();
    SBAR(); qkt(pA0, pA1, K_lds, qr, r32, hi);
    finishSM(pB0, pB1, alB, l_reg, pa0, pa1, pa2, pa3); SBAR();
    if (SDEPTH == 1 || j + 3 < NT) SLOAD(SE, (j + 1 + SDEPTH) * KVBLK); SBAR();
    pv_d0(o, vb0 + (int)SHM_V, pa0, pa1, pa2, pa3); partialSM(pA0, pA1, m_reg, mnA, alA);
    __syncthreads(); SWAIT(); SWRITE(1, SO);
    RESC(alA); __syncthreads();
  }
  SBAR(); qkt(pB0, pB1, (bf16*)((char*)K_lds + SHM_K), qr, r32, hi);
  finishSM(pA0, pA1, alA, l_reg, pa0, pa1, pa2, pa3); SBAR();
  pv_d0(o, vb0, pa0, pa1, pa2, pa3); partialSM(pB0, pB1, m_reg, mnB, alB);
  __syncthreads(); RESC(alB);
  finishSM(pB0, pB1, alB, l_reg, pa0, pa1, pa2, pa3); SBAR();
  pv_d0(o, vb0 + (int)SHM_V, pa0, pa1, pa2, pa3);
  if (hi == 0) li_l[r32] = l_reg; asm volatile("s_waitcnt lgkmcnt(0)" ::: "memory");
  float rli[16];
#pragma unroll
  for (int r = 0; r < 16; ++r) rli[r] = __builtin_amdgcn_rcpf(li_l[crow(r, hi)]);
  unsigned short* Ow = (unsigned short*)Ob + (long)(wid * QBLK) * LDO;
#pragma unroll
  for (int r = 0; r < 16; ++r) { int orow = crow(r, hi);
    for (int d0 = 0; d0 < 4; ++d0) Ow[(long)orow * LDO + d0 * 32 + r32] = (unsigned short)(cvtpk(o[d0][r] * rli[r], 0.f) & 0xffffu); }
#undef SLOAD
#undef SWRITE
#undef SWAIT
#undef RESC
}
}

#define LAS __attribute__((address_space(3)))
typedef unsigned short bf16_t;
typedef float f32x4 __attribute__((ext_vector_type(4)));
typedef float f32x2 __attribute__((ext_vector_type(2)));
typedef unsigned u32x2 __attribute__((ext_vector_type(2)));
typedef unsigned u32x4 __attribute__((ext_vector_type(4)));

constexpr int BATCH = 2, SEQ = 8192, DM = 1024, TT = BATCH * SEQ, DFF = 2816, NQKV = 1536, DEPTH = 4;
constexpr int NTHR = 512, NWAVES = 8;
constexpr int LDS_BYTES = 147456;
constexpr size_t MiB = 1u << 20, KiB = 1024;
constexpr size_t WS_W = 1 * MiB, WS_MOD = 46 * MiB, WS_VF = 47 * MiB, WS_H = 79 * MiB, WS_BIG = 111 * MiB, WS_END = 575 * MiB;
constexpr size_t W_F0G = 0, W_F0D = 11 * MiB, W_F1G = 16 * MiB + 512 * KiB, W_F1D = 27 * MiB + 512 * KiB, W_MX = 33 * MiB;
constexpr size_t MX_QKV = 0, MX_AWO = 3 * MiB;
constexpr size_t MX_WR = 0, MX_RWO = 6 * MiB, MX_L1 = 8 * MiB  , MX_L2W = 10 * MiB, MX_L2A = 10 * MiB + 512 * KiB, MX_L2G = 11 * MiB, MX_L2V = 11 * MiB + 256 * KiB;
constexpr size_t B_HID = 0, B_QKV = 0;
constexpr size_t B_MIX = 0  , B_R = 192 * MiB, B_K = 224 * MiB, B_V = 256 * MiB, B_L1 = 288 * MiB  , B_G = 304 * MiB, B_A = 336 * MiB, B_Y1 = 400 * MiB;
constexpr size_t B_DEC = 0, B_Y0 = 128 * MiB, B_POST = 0;

struct Params { const float* in[34]; int ph_lo, ph_hi; };

__device__ __forceinline__ unsigned pk2(float lo, float hi) { return pg8::cvt_pk_bf16(lo, hi); }
__device__ __forceinline__ float bflo(unsigned w) { return __uint_as_float(w << 16); }
__device__ __forceinline__ float bfhi(unsigned w) { return __uint_as_float(w & 0xffff0000u); }
__device__ __forceinline__ f32x4 ld_bf4(const bf16_t* p) { const u32x2 w = *(const u32x2*)p; return (f32x4){bflo(w.x), bfhi(w.x), bflo(w.y), bfhi(w.y)}; }
__device__ __forceinline__ f32x4 un_bf4(u32x2 w) { return (f32x4){bflo(w.x), bfhi(w.x), bflo(w.y), bfhi(w.y)}; }
__device__ __forceinline__ void st_bf4(bf16_t* p, f32x4 v) { u32x2 w; w.x = pk2(v.x, v.y); w.y = pk2(v.z, v.w); *(u32x2*)p = w; }
__device__ __forceinline__ float wave_sum(float v) {
#pragma unroll
    for (int o = 1; o < 64; o <<= 1) v += __shfl_xor(v, o);
    return v;
}
__device__ __forceinline__ float sum16(float v) {
#pragma unroll
    for (int o = 1; o < 16; o <<= 1) v += __shfl_xor(v, o);
    return v;
}
__device__ __forceinline__ float dot4(f32x4 a, f32x4 b) { return (a.x * b.x + a.y * b.y) + (a.z * b.z + a.w * b.w); }
template <int CTRL> __device__ __forceinline__ float dpp_mov(float v) { return __int_as_float(__builtin_amdgcn_update_dpp(0, __float_as_int(v), CTRL, 0xf, 0xf, false)); }
__device__ __forceinline__ float row_sum16(float p) {
    p += dpp_mov<0xB1>(p); p += dpp_mov<0x4E>(p); p += dpp_mov<0x141>(p); p += dpp_mov<0x140>(p); return p;
}
#define LDS_WAIT() asm volatile("s_waitcnt lgkmcnt(0)" ::: "memory")

__device__ __forceinline__ void transpose_item(const float* W, int K, int N, bf16_t* WT, int mode, LAS float* scr, int item, int lane) {
    const int nblk = N / 32, kb = item / nblk, nb = item % nblk, k0 = 64 * kb, n0 = 32 * nb;
    const int drow0 = (mode == 0) ? n0 : ((n0 >> 7) * 256 + (n0 & 127) + (mode == 2 ? 128 : 0));
#pragma unroll 8
    for (int i = 0; i < 32; ++i) { const int kk = 2 * i + (lane >> 5); scr[kk * 33 + (lane & 31)] = W[(size_t)(k0 + kk) * N + n0 + (lane & 31)]; }
    LDS_WAIT();
    const int c = lane & 7;
#pragma unroll
    for (int j = 0; j < 4; ++j) { const int n = (lane >> 3) + 8 * j; const LAS float* s = scr + (8 * c) * 33 + n;
        u32x4 o; o.x = pk2(s[0 * 33], s[1 * 33]); o.y = pk2(s[2 * 33], s[3 * 33]); o.z = pk2(s[4 * 33], s[5 * 33]); o.w = pk2(s[6 * 33], s[7 * 33]);
        *(u32x4*)(WT + (size_t)(drow0 + n) * K + k0 + 8 * c) = o; }
    LDS_WAIT();
}
struct TJob { const float* src; bf16_t* dst; int K, N, mode, nitems; };
__device__ __forceinline__ TJob get_job(const Params& P, int z, unsigned char* ws, int L, int jb) {
    TJob j; unsigned char* wb = ws + WS_W; const int jm = L >> 1; const bool attn = !(L & 1);
    if (jb < 6) {
        const int f = jb / 3, q = jb % 3; const size_t wo = (size_t)(L * 2 + f) * DM * DFF;
        if (q == 0)      { j.src = P.in[5 + z] + wo; j.K = DM; j.N = DFF; j.mode = 1; j.dst = (bf16_t*)(wb + (f ? W_F1G : W_F0G)); }
        else if (q == 1) { j.src = P.in[6 + z] + wo; j.K = DM; j.N = DFF; j.mode = 2; j.dst = (bf16_t*)(wb + (f ? W_F1G : W_F0G)); }
        else             { j.src = P.in[7 + z] + wo; j.K = DFF; j.N = DM; j.mode = 0; j.dst = (bf16_t*)(wb + (f ? W_F1D : W_F0D)); }
    } else if (attn) {
        j.mode = 0; j.K = DM;
        if (jb == 6) { j.src = P.in[8 + z] + (size_t)jm * DM * NQKV; j.N = NQKV; j.dst = (bf16_t*)(wb + W_MX + MX_QKV); }
        else         { j.src = P.in[11 + z] + (size_t)jm * DM * DM; j.N = DM; j.dst = (bf16_t*)(wb + W_MX + MX_AWO); }
    } else {
        j.mode = 0; j.K = DM; j.N = DM;
        if (jb < 9) { j.src = P.in[13 + z] + (size_t)(jm * 3 + (jb - 6)) * DM * DM; j.dst = (bf16_t*)(wb + W_MX + MX_WR + (size_t)(jb - 6) * 2 * MiB); }
        else        { j.src = P.in[27 + z] + (size_t)jm * DM * DM; j.dst = (bf16_t*)(wb + W_MX + MX_RWO); }
    }
    j.nitems = (j.K / 64) * (j.N / 32);
    return j;
}
__device__ __forceinline__ void fill_l1(bf16_t* dst, const float* src, int nsrc, int rank, int gtid, int gthreads) {
    for (int i = gtid; i < 256 * 512; i += gthreads) { const int n = i >> 9, k = (i & 511) * 2; float a = 0.f, b = 0.f;
        if (n < nsrc * rank) { const float* s = src + (size_t)(n / rank) * 1024 * rank + (n % rank); a = s[(size_t)k * rank]; b = s[(size_t)(k + 1) * rank]; }
        ((unsigned*)dst)[i] = pk2(a, b); }
}
__device__ __forceinline__ void fill_l2bd(bf16_t* dst, const float* src, int gtid, int gthreads) {
    for (int i = gtid; i < 2048 * 64; i += gthreads) { const int n = i >> 6, k = (i & 63) * 2, dir = n >> 10, col = n & 1023, kk = k - 64 * dir; float a = 0.f, b = 0.f;
        if (kk >= 0 && kk < 64) { a = src[(size_t)(dir * 64 + kk) * 1024 + col]; b = src[(size_t)(dir * 64 + kk + 1) * 1024 + col]; }
        ((unsigned*)dst)[i] = pk2(a, b); }
}
__device__ __forceinline__ void fill_l2(bf16_t* dst, const float* src, int rank, int gtid, int gthreads) {
    for (int i = gtid; i < 1024 * 64; i += gthreads) { const int n = i >> 6, k = (i & 63) * 2; float a = 0.f, b = 0.f;
        if (k < rank) { a = src[(size_t)k * 1024 + n]; b = src[(size_t)(k + 1) * 1024 + n]; }
        ((unsigned*)dst)[i] = pk2(a, b); }
}
__device__ __forceinline__ void mods_phase(const Params& P, int z, unsigned char* ws, LAS unsigned char* lds, int tid) {
    LAS float* cs = (LAS float*)lds;
    LAS float* red = cs + 2048;
    float* MOD = (float*)(ws + WS_MOD);
    for (int i = tid; i < 2048; i += NTHR) { const float c = P.in[1 + z][i]; cs[i] = c * pg8::fsigmoid(c); }
    __syncthreads();
    const int cgi = tid & 31, dp = tid >> 5;
    for (int item = blockIdx.x; item < 4 * 72; item += gridDim.x) {
        const int l = item / 72, cb = item % 72, col = cb * 128 + cgi * 4;
        const float* w = P.in[2 + z] + (size_t)l * DM * 9216 + (size_t)(dp * 64) * 9216 + col;
        f32x4 a0 = (f32x4){0.f, 0.f, 0.f, 0.f}, a1 = a0;
#pragma unroll 8
        for (int d = 0; d < 64; ++d) { const f32x4 wv = *(const f32x4*)(w + (size_t)d * 9216); const float c0 = cs[dp * 64 + d], c1 = cs[1024 + dp * 64 + d]; a0 += wv * c0; a1 += wv * c1; }
        *(LAS f32x4*)(red + (dp * 32 + cgi) * 8) = a0; *(LAS f32x4*)(red + (dp * 32 + cgi) * 8 + 4) = a1;
        __syncthreads();
        if (tid < 256) { const int ci = tid >> 3, e = tid & 7; float s = 0.f;
#pragma unroll
            for (int p = 0; p < 16; ++p) s += red[(p * 32 + ci) * 8 + e];
            const int b = e >> 2, cc = cb * 128 + ci * 4 + (e & 3);
            MOD[(size_t)(l * 2 + b) * 9216 + cc] = s + P.in[3 + z][(size_t)l * 9216 + cc]; }
        __syncthreads();
    }
}
__device__ __forceinline__ const float* mod_vec(unsigned char* ws, int L, int j) { return (const float*)(ws + WS_MOD) + (size_t)(L * 2) * 9216 + (size_t)j * 1024; }

__device__ __forceinline__ void norm_phase(const float* x, bf16_t* H, const float* g, const float* sh, const float* sc, int gw, int ngw, int lane) {
    for (int m = gw; m < TT; m += ngw) {
        const int b = m >> 13; const float* xr = x + (size_t)m * DM + 4 * lane;
        f32x4 v[4]; float ss = 0.f;
#pragma unroll
        for (int j = 0; j < 4; ++j) { v[j] = *(const f32x4*)(xr + 256 * j); ss += dot4(v[j], v[j]); }
        const float rstd = 1.0f / sqrtf(wave_sum(ss) * (1.0f / DM) + 1e-6f);
#pragma unroll
        for (int j = 0; j < 4; ++j) { const int c = 4 * lane + 256 * j;
            const f32x4 gv = *(const f32x4*)(g + c), scv = *(const f32x4*)(sc + b * 9216 + c), shv = *(const f32x4*)(sh + b * 9216 + c);
            st_bf4(H + (size_t)m * DM + c, v[j] * rstd * gv * (1.0f + scv) + shv); }
    }
}
__device__ __forceinline__ void final_norm_phase(float* x, const float* g, int gw, int ngw, int lane) {
    for (int m = gw; m < TT; m += ngw) {
        float* xr = x + (size_t)m * DM + 4 * lane;
        f32x4 v[4]; float ss = 0.f;
#pragma unroll
        for (int j = 0; j < 4; ++j) { v[j] = *(const f32x4*)(xr + 256 * j); ss += dot4(v[j], v[j]); }
        const float rstd = 1.0f / sqrtf(wave_sum(ss) * (1.0f / DM) + 1e-6f);
#pragma unroll
        for (int j = 0; j < 4; ++j) { const f32x4 gv = *(const f32x4*)(g + 4 * lane + 256 * j); *(f32x4*)(xr + 256 * j) = v[j] * rstd * gv; }
    }
}
__device__ __forceinline__ void mix_phase(const float* x, bf16_t* MIX, const float* g, const float* sh, const float* sc, const float* mix, int gw, int ngw, int lane) {
    for (int m = gw; m < TT; m += ngw) {
        const int b = m >> 13, t = m & (SEQ - 1); const bool hp = t > 0, hn = t < SEQ - 1;
        const float* xr = x + (size_t)m * DM + 4 * lane;
        f32x4 vc[4], vp[4], vn[4]; float sc_ = 0.f, sp_ = 0.f, sn_ = 0.f;
#pragma unroll
        for (int j = 0; j < 4; ++j) {
            vc[j] = *(const f32x4*)(xr + 256 * j);
            vp[j] = hp ? *(const f32x4*)(xr - DM + 256 * j) : (f32x4){0.f, 0.f, 0.f, 0.f};
            vn[j] = hn ? *(const f32x4*)(xr + DM + 256 * j) : (f32x4){0.f, 0.f, 0.f, 0.f};
            sc_ += dot4(vc[j], vc[j]); sp_ += dot4(vp[j], vp[j]); sn_ += dot4(vn[j], vn[j]);
        }
        const float rc = 1.0f / sqrtf(wave_sum(sc_) * (1.0f / DM) + 1e-6f), rp = 1.0f / sqrtf(wave_sum(sp_) * (1.0f / DM) + 1e-6f), rn = 1.0f / sqrtf(wave_sum(sn_) * (1.0f / DM) + 1e-6f);
#pragma unroll
        for (int j = 0; j < 4; ++j) { const int c = 4 * lane + 256 * j;
            const f32x4 gv = *(const f32x4*)(g + c) * (1.0f + *(const f32x4*)(sc + b * 9216 + c)), shv = *(const f32x4*)(sh + b * 9216 + c);
            const f32x4 h = vc[j] * rc * gv + shv;
            const f32x4 p = hp ? vp[j] * rp * gv + shv : (f32x4){0.f, 0.f, 0.f, 0.f};
            const f32x4 n = hn ? vn[j] * rn * gv + shv : (f32x4){0.f, 0.f, 0.f, 0.f};
            const f32x4 xx = 0.5f * (p + n) - h;
#pragma unroll
            for (int q = 0; q < 6; ++q) { const f32x4 mv = *(const f32x4*)(mix + q * DM + c); st_bf4(MIX + (size_t)q * TT * DM + (size_t)m * DM + c, h + xx * mv); }
        }
    }
}
__device__ __forceinline__ void qkrope_phase(bf16_t* QKV, const float* qg, const float* kg, int gw, int ngw, int lane) {
    const int p = lane;
    const float invf = __builtin_amdgcn_exp2f(-(float)(p & 31) * 0.4152410118609203f);
    for (int it = gw; it < TT * 10; it += ngw) {
        const int m = it / 10, hd = it - m * 10, t = m & (SEQ - 1);
        unsigned* ptr = (unsigned*)(QKV + (size_t)m * NQKV + hd * 128) + p;
        const unsigned w = *ptr; const float x0 = bflo(w), x1 = bfhi(w);
        const float rstd = 1.0f / sqrtf(wave_sum(x0 * x0 + x1 * x1) * (1.0f / 128.0f) + 1e-6f);
        const float* gn = hd < 8 ? qg : kg;
        const float y0 = x0 * rstd * gn[2 * p], y1 = x1 * rstd * gn[2 * p + 1];
        const float pos = (p < 32) ? (float)((t >> 6) - 64) : (float)((t & 63) - 32);
        float rev = pos * invf * 0.15915494309189535f; rev -= rintf(rev);
        const float s = __builtin_amdgcn_sinf(rev), c = __builtin_amdgcn_cosf(rev);
        *ptr = pk2(y0 * c - y1 * s, y0 * s + y1 * c);
    }
}
struct PostIn { const float *Y0, *Y1; const bf16_t *R, *K, *V, *A, *G, *VF, *VG; const float *k_a, *r_k, *ln_w, *ln_b; bf16_t* O; int has_vres; };
__device__ __forceinline__ void post_phase(const PostIn& I, int gw, int ngw, int lane) {
    for (int m = gw; m < TT; m += ngw) {
#pragma unroll
        for (int j = 0; j < 4; ++j) { const int c = 4 * lane + 256 * j; const size_t o = (size_t)m * DM + c;
            const f32x4 y = *(const f32x4*)(I.Y0 + o) + *(const f32x4*)(I.Y1 + o);
            const float mu = sum16((y.x + y.y) + (y.z + y.w)) * (1.0f / 64.0f);
            const f32x4 d = y - mu;
            const float var = sum16(dot4(d, d)) * (1.0f / 64.0f);
            const float rs = 1.0f / sqrtf(var + 64e-5f);
            const f32x4 r = ld_bf4(I.R + o), k = ld_bf4(I.K + o); f32x4 v = ld_bf4(I.V + o);
            const f32x4 a0 = ld_bf4(I.A + (size_t)m * 2048 + c), a1 = ld_bf4(I.A + (size_t)m * 2048 + 1024 + c);
            const f32x4 ka = *(const f32x4*)(I.k_a + c), rk = *(const f32x4*)(I.r_k + c);
            if (I.has_vres) { const f32x4 vf = ld_bf4(I.VF + o), vg = ld_bf4(I.VG + o); v = v + (vf - v) * vg; }
            const f32x4 kd = k * (1.0f + (a0 - 1.0f) * ka) + k * (1.0f + (a1 - 1.0f) * ka);
            const float bonus = sum16(dot4(r * kd, rk));
            const f32x4 lw = *(const f32x4*)(I.ln_w + c), lb = *(const f32x4*)(I.ln_b + c), gg = ld_bf4(I.G + o);
            st_bf4(I.O + o, (d * rs * lw + lb + bonus * v) * gg);
        }
    }
}
constexpr int TC = 32, SC_ARR = TC * 64 * 4, SC_BUF = 5 * SC_ARR + 2 * TC * 16 * 4;
struct ScanIn { const bf16_t *R, *K, *V, *A, *VF, *VG; const float* DEC; float *Y0, *Y1; const float *k_k, *k_a; int has_vres; };
struct ScanRegs { u32x2 r, k, v, a, vf, vg; f32x4 dec; };
__device__ __forceinline__ void scan_load(const ScanIn& I, ScanRegs (&rg)[2], int c, int st, int dir, int b, int h, int rq) {
#pragma unroll
    for (int i = 0; i < 2; ++i) { const int item = st + 256 * i, tl = item >> 4, c4 = (item & 15) * 4, ts = c * TC + tl, ta = dir ? SEQ - 1 - ts : ts;
        const size_t grow = (size_t)b * SEQ + ta, o = grow * DM + h * 64 + c4, o2 = grow * 2048 + dir * 1024 + h * 64 + c4;
        rg[i].r = *(const u32x2*)(I.R + o); rg[i].k = *(const u32x2*)(I.K + o); rg[i].v = *(const u32x2*)(I.V + o);
        rg[i].a = *(const u32x2*)(I.A + o2); rg[i].dec = *(const f32x4*)(I.DEC + o2);
        if (I.has_vres && (c4 >> 4) == rq) { rg[i].vf = *(const u32x2*)(I.VF + o); rg[i].vg = *(const u32x2*)(I.VG + o); } }
}
__device__ __forceinline__ void scan_stage(const ScanIn& I, const ScanRegs (&rg)[2], LAS unsigned char* buf, int st, int rq, f32x4 kkv, f32x4 kav) {
#pragma unroll
    for (int i = 0; i < 2; ++i) { const int item = st + 256 * i, tl = item >> 4, c4 = (item & 15) * 4;
        const f32x4 k = un_bf4(rg[i].k), a = un_bf4(rg[i].a), r = un_bf4(rg[i].r);
        const f32x4 kks = k * kkv; const float ss = sum16(dot4(kks, kks)); const float inv = 1.0f / fmaxf(sqrtf(ss), 1e-12f);
        const f32x4 kk = kks * inv, kd = k * (1.0f + (a - 1.0f) * kav), ka = kk * a;
        LAS f32x4* base = (LAS f32x4*)(buf + (tl * 64 + c4) * 4);
        base[0] = rg[i].dec; base[SC_ARR / 16] = kk; base[2 * SC_ARR / 16] = ka; base[3 * SC_ARR / 16] = kd; base[4 * SC_ARR / 16] = r;
        if ((c4 >> 4) == rq) { f32x4 v = un_bf4(rg[i].v); if (I.has_vres) { const f32x4 vf = un_bf4(rg[i].vf), vg = un_bf4(rg[i].vg); v = v + (vf - v) * vg; }
            *(LAS f32x4*)(buf + 5 * SC_ARR + (tl * 16 + (c4 & 15)) * 4) = v; } }
}
__device__ __forceinline__ void scan_writey(const ScanIn& I, const LAS unsigned char* buf, int c, int st, int dir, int b, int h, int rq) {
    const LAS float* yb = (const LAS float*)(buf + 5 * SC_ARR + TC * 16 * 4); float* Y = dir ? I.Y1 : I.Y0;
#pragma unroll
    for (int i = 0; i < 2; ++i) { const int item = st + 256 * i, tl = item >> 4, rl = item & 15, ts = c * TC + tl, ta = dir ? SEQ - 1 - ts : ts;
        Y[((size_t)b * SEQ + ta) * DM + h * 64 + rq * 16 + rl] = yb[item]; }
}
__device__ __forceinline__ void scan_unit(const ScanIn& I, LAS unsigned char* lds, int unit, int tid) {
    const int dir = unit >> 7, b = (unit >> 6) & 1, h = (unit >> 2) & 15, rq = unit & 3;
    constexpr int NC = SEQ / TC;
    const bool stager = tid >= 256; const int st = tid & 255;
    f32x4 s = (f32x4){0.f, 0.f, 0.f, 0.f};
    ScanRegs rg[2]; f32x4 kkv = s, kav = s;
    if (stager) { const int c4 = (st & 15) * 4; kkv = *(const f32x4*)(I.k_k + h * 64 + c4); kav = *(const f32x4*)(I.k_a + h * 64 + c4);
        scan_load(I, rg, 0, st, dir, b, h, rq); scan_stage(I, rg, lds, st, rq, kkv, kav); scan_load(I, rg, 1, st, dir, b, h, rq); }
    __syncthreads();
    for (int c = 0; c < NC; ++c) {
        LAS unsigned char* cur = lds + (c & 1) * SC_BUF; LAS unsigned char* nxt = lds + ((c + 1) & 1) * SC_BUF;
        if (stager) {
            if (c + 1 < NC) scan_stage(I, rg, nxt, st, rq, kkv, kav);
            if (c + 2 < NC) scan_load(I, rg, c + 2, st, dir, b, h, rq);
            if (c > 0) scan_writey(I, nxt, c - 1, st, dir, b, h, rq);
        } else {
            const int rl = tid >> 4, ks = tid & 15;
            const LAS f32x4* wq = (const LAS f32x4*)cur + ks; const LAS float* vb = (const LAS float*)(cur + 5 * SC_ARR) + rl; LAS float* yb = (LAS float*)(cur + 5 * SC_ARR + TC * 16 * 4) + rl;
#pragma unroll 4
            for (int tl = 0; tl < TC; ++tl) {
                const f32x4 w = wq[tl * 16], kk = wq[tl * 16 + SC_ARR / 16], ka = wq[tl * 16 + 2 * SC_ARR / 16], kd = wq[tl * 16 + 3 * SC_ARR / 16], r = wq[tl * 16 + 4 * SC_ARR / 16];
                const float vv = vb[tl * 16];
                const float sa = -row_sum16(dot4(s, kk));
                s = s * w + (sa * ka + vv * kd);
                const float y = row_sum16(dot4(s, r));
                if (ks == 0) yb[tl * 16] = y;
            }
        }
        __syncthreads();
    }
    if (stager) scan_writey(I, lds + ((NC - 1) & 1) * SC_BUF, NC - 1, st, dir, b, h, rq);
    __syncthreads();
}

constexpr int PH_PER_LAYER = 13, NPHASES = DEPTH * PH_PER_LAYER + 1;

__global__ void __launch_bounds__(NTHR, 2) fwd_megakernel(Params P) {
    extern __shared__ __attribute__((aligned(16))) unsigned char lds_raw[];
    cg::grid_group grid = cg::this_grid();
    LAS unsigned char* lds = (LAS unsigned char*)lds_raw;

    for (int ph = P.ph_lo; ph < P.ph_hi; ++ph) {
        int z = 0; asm volatile("" : "+s"(z));
        unsigned char* ws = (unsigned char*)P.in[33 + z];
        float* X = (float*)P.in[32 + z];
        bf16_t* H = (bf16_t*)(ws + WS_H);
        unsigned char* wb = ws + WS_W; unsigned char* big = ws + WS_BIG;
        const int tid = mk_tid(), lane = tid & 63, wave = __builtin_amdgcn_readfirstlane(tid >> 6);
        const int gw = blockIdx.x * NWAVES + wave, ngw = gridDim.x * NWAVES, gtid = blockIdx.x * NTHR + tid, gthreads = gridDim.x * NTHR;
        const int L = ph / PH_PER_LAYER, k = ph - L * PH_PER_LAYER, jm = L >> 1;
        const bool attn = !(L & 1);
        if (ph == NPHASES - 1) {
            final_norm_phase(X, P.in[31 + z], gw, ngw, lane);
        } else if (k == 0) {
            LAS float* scr = (LAS float*)(lds + wave * 16384);
            const int njobs = attn ? 8 : 10; int total = 0;
            for (int jb = 0; jb < njobs; ++jb) total += get_job(P, z, ws, L, jb).nitems;
            for (int it = gw; it < total; it += ngw) {
                int r = it;
                for (int jb = 0; jb < njobs; ++jb) { const TJob j = get_job(P, z, ws, L, jb); if (r < j.nitems) { transpose_item(j.src, j.K, j.N, j.dst, j.mode, scr, r, lane); break; } r -= j.nitems; }
            }
            if (!attn) {
                unsigned char* mx = wb + W_MX;
                fill_l1((bf16_t*)(mx + MX_L1), P.in[15 + z] + (size_t)jm * 2 * 1024 * 64, 2, 64, gtid, gthreads);
                fill_l1((bf16_t*)(mx + MX_L1 + 512 * KiB), P.in[18 + z] + (size_t)jm * 2 * 1024 * 64, 2, 64, gtid, gthreads);
                fill_l1((bf16_t*)(mx + MX_L1 + 1024 * KiB), P.in[20 + z] + (size_t)jm * 1024 * 128, 1, 128, gtid, gthreads);
                if (jm > 0) fill_l1((bf16_t*)(mx + MX_L1 + 1536 * KiB), P.in[29 + z] + (size_t)(jm - 1) * 1024 * 32, 1, 32, gtid, gthreads);
                fill_l2bd((bf16_t*)(mx + MX_L2W), P.in[16 + z] + (size_t)jm * 2 * 64 * 1024, gtid, gthreads);
                fill_l2bd((bf16_t*)(mx + MX_L2A), P.in[19 + z] + (size_t)jm * 2 * 64 * 1024, gtid, gthreads);
                fill_l2((bf16_t*)(mx + MX_L2G), P.in[21 + z] + (size_t)jm * 128 * 1024, 128, gtid, gthreads);
                if (jm > 0) fill_l2((bf16_t*)(mx + MX_L2V), P.in[30 + z] + (size_t)(jm - 1) * 32 * 1024, 32, gtid, gthreads);
            }
            if (L == 0) { __syncthreads(); mods_phase(P, z, ws, lds, tid); }
        } else if (k == 1 || k == 10 || (k == 4 && attn)) {
            const int sub = (k == 1) ? 0 : (k == 4 ? 1 : 2);
            const float* xin = (L == 0 && k == 1) ? P.in[0 + z] : X;
            norm_phase(xin, H, P.in[4 + z] + (size_t)(L * 3 + sub) * DM, mod_vec(ws, L, 3 * sub), mod_vec(ws, L, 3 * sub + 1), gw, ngw, lane);
        } else if (k == 2 || k == 11) {
            const int f = (k == 11);
            pg8::Gemm g{H, (const bf16_t*)(wb + (f ? W_F1G : W_F0G)), TT, 2 * DFF, DM};
            pg8::GenOrder S; S.so.init(TT, 2 * DFF, gridDim.x, blockIdx.x); S.single = 0; S.pm = 0; S.pn = 0;
            pg8::EpiSwiglu E{(bf16_t*)(big + B_HID), DFF};

#ifndef SKIP_SWI
            pg8::gemm_phase<pg8::EpiSwiglu, pg8::GenOrder, true, true>(lds, g, S, E);
#endif

        } else if (k == 3 || k == 12 || k == 9) {
            pg8::Gemm g; pg8::EpiResid E;
            if (k == 9) {
                g = pg8::Gemm{attn ? H : (const bf16_t*)(big + B_POST), (const bf16_t*)(wb + W_MX + (attn ? MX_AWO : MX_RWO)), TT, DM, DM};
                E = pg8::EpiResid{X, X, mod_vec(ws, L, 5), 9216, 1.0f};
            } else {
                const int f = (k == 12);
                g = pg8::Gemm{(const bf16_t*)(big + B_HID), (const bf16_t*)(wb + (f ? W_F1D : W_F0D)), TT, DM, DFF};
                E = pg8::EpiResid{(L == 0 && k == 3) ? P.in[0 + z] : X, X, mod_vec(ws, L, f ? 8 : 2), 9216, 0.5f};
            }
            pg8::GenOrder S; S.so.init(TT, DM, gridDim.x, blockIdx.x); S.single = 0; S.pm = 0; S.pn = 0;

#ifndef SKIP_RES
            pg8::gemm_phase<pg8::EpiResid, pg8::GenOrder, true, true>(lds, g, S, E);
#endif

        } else if (k == 4) {
            mix_phase(X, (bf16_t*)(big + B_MIX), P.in[4 + z] + (size_t)(L * 3 + 1) * DM, mod_vec(ws, L, 3), mod_vec(ws, L, 4), P.in[12 + z] + (size_t)jm * 6 * DM, gw, ngw, lane);
        } else if (k == 5 || (k == 6 && !attn)) {
            const int nsub = attn ? 1 : (k == 5 ? 4 : 3);
            bf16_t* vdst = (jm == 0) ? (bf16_t*)(ws + WS_VF) : (bf16_t*)(big + B_V);
            for (int s = 0; s < nsub; ++s) {
                pg8::Gemm g; pg8::EpiBf16Out E; pg8::GenOrder S; S.single = 0; S.pm = 0; S.pn = 0; int N = DM;
                if (attn) { g = pg8::Gemm{H, (const bf16_t*)(wb + W_MX + MX_QKV), TT, NQKV, DM}; E = pg8::EpiBf16Out{(bf16_t*)(big + B_QKV), NQKV, nullptr, 0, NQKV}; N = NQKV; }
                else if (k == 5 && s < 3) {
                    const int mixi = (s == 0) ? 0 : (s == 1 ? 2 : 3);
                    bf16_t* dst = (s == 0) ? (bf16_t*)(big + B_R) : (s == 1 ? (bf16_t*)(big + B_K) : vdst);
                    g = pg8::Gemm{(const bf16_t*)(big + B_MIX) + (size_t)mixi * TT * DM, (const bf16_t*)(wb + W_MX + MX_WR + (size_t)s * 2 * MiB), TT, DM, DM};
                    E = pg8::EpiBf16Out{dst, DM, nullptr, 0, DM};
                } else if (k == 5) {
                    const int q = blockIdx.x >> 6; const int mixi = (q == 0) ? 1 : (q == 1 ? 4 : (q == 2 ? 5 : 3));
                    g = pg8::Gemm{(const bf16_t*)(big + B_MIX) + (size_t)mixi * TT * DM, (const bf16_t*)(wb + W_MX + MX_L1 + (size_t)q * 512 * KiB), TT, 256, DM};
                    E = pg8::EpiBf16Out{(bf16_t*)(big + B_L1 + (size_t)q * 4 * MiB), 128, nullptr, (q == 0) ? 1 : (q == 2 ? 2 : 0), 128};
                    S.single = 1; S.pm = (blockIdx.x < 256 && !(q == 3 && jm == 0)) ? (int)(blockIdx.x & 63) : -1; S.pn = 0; N = 256;
                } else if (s == 0) {
                    g = pg8::Gemm{(const bf16_t*)(big + B_L1 + 4 * MiB), (const bf16_t*)(wb + W_MX + MX_L2A), TT, 2048, 128}; N = 2048;
                    E = pg8::EpiBf16Out{(bf16_t*)(big + B_A), 2048, P.in[17 + z] + (size_t)jm * 2 * DM, 2, 2048};
                } else if (s == 1) {
                    g = pg8::Gemm{(const bf16_t*)(big + B_L1 + 8 * MiB), (const bf16_t*)(wb + W_MX + MX_L2G), TT, DM, 128};
                    E = pg8::EpiBf16Out{(bf16_t*)(big + B_G), DM, nullptr, 0, DM};
                } else {
                    g = pg8::Gemm{(const bf16_t*)(big + B_L1 + 12 * MiB), (const bf16_t*)(wb + W_MX + MX_L2V), TT, DM, 128};
                    E = pg8::EpiBf16Out{H, DM, P.in[28 + z], 2, DM};
                    if (jm == 0) { S.single = 1; S.pm = -1; }
                }
                if (!S.single) S.so.init(TT, N, gridDim.x, blockIdx.x);

#ifndef SKIP_BF
                pg8::gemm_phase<pg8::EpiBf16Out, pg8::GenOrder, true, true>(lds, g, S, E);
#endif

            }
            if (!attn && k == 6) {
                pg8::Gemm g{(const bf16_t*)(big + B_L1), (const bf16_t*)(wb + W_MX + MX_L2W), TT, 2048, 128};
                pg8::EpiF32Out E{(float*)(big + B_DEC), 2048, P.in[14 + z] + (size_t)jm * 2 * DM, 3};
                pg8::GenOrder S; S.so.init(TT, 2048, gridDim.x, blockIdx.x); S.single = 0; S.pm = 0; S.pn = 0;

#ifndef SKIP_F32
                pg8::gemm_phase<pg8::EpiF32Out, pg8::GenOrder, true, true>(lds, g, S, E);
#endif

            }
        } else if (k == 6) {
            qkrope_phase((bf16_t*)(big + B_QKV), P.in[9 + z] + (size_t)jm * 128, P.in[10 + z] + (size_t)jm * 128, gw, ngw, lane);
        } else if (k == 7 && attn) {
            const att::bf16* qkv = (const att::bf16*)(big + B_QKV);
            for (int u = blockIdx.x; u < 512; u += gridDim.x) {
                const int b = u >> 8, hq = (u >> 5) & 7, qb = u & 31; const size_t r0 = (size_t)b * SEQ;

#ifndef SKIP_ATT
                att::attn_dense_body<att::bf16>(qkv + (r0 + qb * 256) * NQKV + hq * 128, qkv + r0 * NQKV + 1024 + (hq >> 2) * 128, qkv + r0 * NQKV + 1280 + (hq >> 2) * 128,
                                                (att::bf16*)H + (r0 + qb * 256) * DM + hq * 128, SEQ, (char*)lds_raw);
#endif

                __syncthreads();
            }
        } else if (k == 7) {
            ScanIn I; I.R = (const bf16_t*)(big + B_R); I.K = (const bf16_t*)(big + B_K); I.V = (jm == 0) ? (const bf16_t*)(ws + WS_VF) : (const bf16_t*)(big + B_V);
            I.A = (const bf16_t*)(big + B_A); I.VF = (const bf16_t*)(ws + WS_VF); I.VG = H; I.DEC = (const float*)(big + B_DEC);
            I.Y0 = (float*)(big + B_Y0); I.Y1 = (float*)(big + B_Y1); I.k_k = P.in[22 + z] + (size_t)jm * DM; I.k_a = P.in[23 + z] + (size_t)jm * DM; I.has_vres = jm > 0;

#ifndef SKIP_SCAN
            for (int u = blockIdx.x; u < 256; u += gridDim.x) scan_unit(I, lds, u, tid);
#endif

        } else if (k == 8 && !attn) {
            PostIn I; I.Y0 = (const float*)(big + B_Y0); I.Y1 = (const float*)(big + B_Y1); I.R = (const bf16_t*)(big + B_R); I.K = (const bf16_t*)(big + B_K);
            I.V = (jm == 0) ? (const bf16_t*)(ws + WS_VF) : (const bf16_t*)(big + B_V); I.A = (const bf16_t*)(big + B_A); I.G = (const bf16_t*)(big + B_G);
            I.VF = (const bf16_t*)(ws + WS_VF); I.VG = H; I.k_a = P.in[23 + z] + (size_t)jm * DM; I.r_k = P.in[24 + z] + (size_t)jm * DM; I.ln_w = P.in[25 + z] + (size_t)jm * DM; I.ln_b = P.in[26 + z] + (size_t)jm * DM;
            I.O = (bf16_t*)(big + B_POST); I.has_vres = jm > 0;
            post_phase(I, gw, ngw, lane);
        }
        if (ph + 1 < P.ph_hi) grid.sync();
    }
}

extern "C" void kernel_launch(void* const* d_in, const int* in_sizes, int n_in, void* d_out, int out_size, void* d_ws, size_t ws_size, hipStream_t stream) {
    static int grid_blocks = 0;
    if (grid_blocks == 0) {
        if (n_in != 32 || out_size != TT * DM || ws_size < WS_END) { fprintf(stderr, "kernel_launch: unexpected shapes: n_in %d out %d ws %zu (need %zu)\n", n_in, out_size, ws_size, (size_t)WS_END); grid_blocks = -1; return; }
        int dev = 0, cus = 0, per_cu = 0;
        hipGetDevice(&dev);
        hipDeviceGetAttribute(&cus, hipDeviceAttributeMultiprocessorCount, dev);
        if (hipFuncSetAttribute((const void*)fwd_megakernel, hipFuncAttributeMaxDynamicSharedMemorySize, LDS_BYTES) != hipSuccess) { fprintf(stderr, "kernel_launch: hipFuncSetAttribute failed\n"); grid_blocks = -1; return; }
        if (hipOccupancyMaxActiveBlocksPerMultiprocessor(&per_cu, (const void*)fwd_megakernel, NTHR, LDS_BYTES) != hipSuccess || per_cu < 1) { fprintf(stderr, "kernel_launch: occupancy query gave %d\n", per_cu); per_cu = 1; }
        (void)hipGetLastError();
        grid_blocks = cus * 1;
        fprintf(stderr, "kernel_launch: cus %d per_cu %d grid %d\n", cus, per_cu, grid_blocks);
    }
    if (grid_blocks < 0) return;
    Params p{};
    for (int i = 0; i < 32; ++i) p.in[i] = (const float*)d_in[i];
    p.in[32] = (const float*)d_out; p.in[33] = (const float*)d_ws;
#ifdef MK_MULTI_LAUNCH
    for (int ph = 0; ph < NPHASES; ++ph) { p.ph_lo = ph; p.ph_hi = ph + 1; hipLaunchKernelGGL(fwd_megakernel, dim3(grid_blocks), dim3(NTHR), LDS_BYTES, stream, p); }
#else
    p.ph_lo = 0; p.ph_hi = NPHASES;
    void* args[] = {&p};
    hipError_t e = hipLaunchCooperativeKernel((const void*)fwd_megakernel, dim3(grid_blocks), dim3(NTHR), args, LDS_BYTES, stream);
    if (e != hipSuccess) fprintf(stderr, "cooperative launch failed: %s (grid %d)\n", hipGetErrorString(e), grid_blocks);
#endif
}
```

```cpp
#include <hip/hip_runtime.h>
#include <hip/hip_cooperative_groups.h>
#include <hip/hip_bf16.h>
#include <cstdio>
#include <cstdint>
namespace cg = cooperative_groups;
__device__ __forceinline__ int mk_tid() { int t = threadIdx.x; asm volatile("" : "+v"(t)); return t; }
#define MK_REP_GEMM 1
namespace pg8 {
#define PG8_LAS __attribute__((address_space(3)))
typedef unsigned short bf16_t;
typedef short bf16x8 __attribute__((ext_vector_type(8)));
typedef float f32x4 __attribute__((ext_vector_type(4)));
typedef unsigned u32x4 __attribute__((ext_vector_type(4)));
constexpr int BM = 256, BK = 64, HALF = 128, HTB = HALF * BK * 2  , STAGE_BYTES = 8 * HTB, NXCD = 8, WGM = 8;

__host__ __device__ __forceinline__ int lds_byte(int r, int c) { const int st = (r >> 4) * 2 + (c >> 5), rr = r & 15, cc = c & 31, ob = rr * 64 + cc * 2; return st * 1024 + (ob ^ (((ob >> 9) & 1) << 5)); }
__host__ __device__ __forceinline__ void stage_rc(int b, int& R, int& C) { const int st = b / 1024, sb = b % 1024, swz = sb ^ (((sb >> 9) & 1) << 5); R = (st >> 1) * 16 + swz / 64; C = (st & 1) * 32 + (swz % 64) / 2; }
__host__ __device__ __forceinline__ int perm32(int rho) { const int n = rho >> 4, i = rho & 15; return 8 * (i >> 2) + 4 * n + (i & 3); }

struct Unit { int pm, pn; };
struct Gemm { const bf16_t* A; const bf16_t* Bt; int M, N, K; };

struct StaticOrder {
    int nM, nN, nwg, G, c;
    __host__ __device__ void init(int M, int N, int G_, int c_) { nM = M / BM; nN = N / BM; nwg = nM * nN; G = G_; c = c_; }
    __host__ __device__ bool next(int i, Unit& u) const {
        const long L = (long)i * G + c; if (L >= nwg) return false;
        int wgid = (int)L; { const int q = nwg / NXCD, r = nwg % NXCD, xcd = wgid % NXCD, off = wgid / NXCD; wgid = (xcd < r ? xcd * (q + 1) : r * (q + 1) + (xcd - r) * q) + off; }
        const int nig = WGM * nN, gid = wgid / nig, fm = gid * WGM, gsz = (nM - fm) < WGM ? (nM - fm) : WGM;
        u.pm = fm + ((wgid % nig) % gsz); u.pn = (wgid % nig) / gsz; return true;
    }
    __device__ __forceinline__ void a_ready(const Unit&) const {}
    __device__ __forceinline__ void done(const Unit&) const {}
};

__device__ __forceinline__ unsigned cvt_pk_bf16(float lo, float hi) { unsigned r; asm volatile("v_cvt_pk_bf16_f32 %0, %1, %2" : "=v"(r) : "v"(lo), "v"(hi)); return r; }
typedef float f32x2 __attribute__((ext_vector_type(2)));
typedef unsigned u32x2 __attribute__((ext_vector_type(2)));

struct GenOrder {
    StaticOrder so; int single, pm, pn;
    __device__ bool next(int i, Unit& u) const {
        if (single) { if (i >= MK_REP_GEMM || pm < 0) return false; u.pm = pm; u.pn = pn; return true; }
        if (MK_REP_GEMM > 1) { const int rounds = (so.nwg - so.c + so.G - 1) / so.G; if (i >= rounds) i -= rounds; }
        return so.next(i, u); }
    __device__ __forceinline__ void a_ready(const Unit&) const {}
    __device__ __forceinline__ void done(const Unit&) const {}
};

__device__ __forceinline__ float fsigmoid(float z) { return __builtin_amdgcn_rcpf(1.0f + __builtin_amdgcn_exp2f(-1.4426950408889634f * z)); }
__device__ __forceinline__ float act_apply(float z, int act) {
    if (act == 1) return 1.0f - 2.0f * __builtin_amdgcn_rcpf(1.0f + __builtin_amdgcn_exp2f(2.8853900817779268f * z));
    if (act == 2) return fsigmoid(z);
    if (act == 3) return __builtin_amdgcn_exp2f(-0.8750387749145276f * fsigmoid(z));
    return z;
}

struct EpiBf16Out {
    static constexpr bool PERM = true, AFTER_DRAIN = false;
    bf16_t* O; int ldc; const float* bias; int act; int nvalid;
    __device__ __forceinline__ void operator()(const f32x4 (&acc)[2][2][4][2], const Unit& u, int, int, int, int) const {
        const int t2 = mk_tid(), wr = t2 >> 8, wc = (t2 >> 6) & 3, fr = t2 & 15, fq = (t2 >> 4) & 3;
        const int row0 = u.pm * BM + wr * 64 + fr;
#pragma unroll
        for (int bj = 0; bj < 2; ++bj) {
            const int colb = u.pn * BM + bj * HALF + wc * 32 + 8 * fq;
            if (colb >= nvalid) continue;
            f32x4 b0 = (f32x4){0.f, 0.f, 0.f, 0.f}, b1 = b0;
            if (bias) { b0 = *(const f32x4*)(bias + colb); b1 = *(const f32x4*)(bias + colb + 4); }
#pragma unroll
            for (int ai = 0; ai < 2; ++ai)
#pragma unroll
                for (int m = 0; m < 4; ++m) {
                    f32x4 v0 = acc[ai][bj][m][0] + b0, v1 = acc[ai][bj][m][1] + b1;
                    if (act != 0) {
#pragma unroll
                        for (int e = 0; e < 4; ++e) { v0[e] = act_apply(v0[e], act); v1[e] = act_apply(v1[e], act); }
                    }
                    u32x4 w; w.x = cvt_pk_bf16(v0[0], v0[1]); w.y = cvt_pk_bf16(v0[2], v0[3]); w.z = cvt_pk_bf16(v1[0], v1[1]); w.w = cvt_pk_bf16(v1[2], v1[3]);
                    *(u32x4*)(O + (size_t)(row0 + ai * HALF + m * 16) * ldc + colb) = w;
                }
        }
    }
};
struct EpiF32Out {
    static constexpr bool PERM = false, AFTER_DRAIN = false;
    float* O; int ldc; const float* bias; int act;
    __device__ __forceinline__ void operator()(const f32x4 (&acc)[2][2][4][2], const Unit& u, int, int, int, int) const {
        const int t2 = mk_tid(), wr = t2 >> 8, wc = (t2 >> 6) & 3, fr = t2 & 15, fq = (t2 >> 4) & 3;
        const int row0 = u.pm * BM + wr * 64 + fr;
#pragma unroll
        for (int bj = 0; bj < 2; ++bj)
#pragma unroll
            for (int n = 0; n < 2; ++n) {
                const int col = u.pn * BM + bj * HALF + wc * 32 + 16 * n + 4 * fq;
                f32x4 b0 = (f32x4){0.f, 0.f, 0.f, 0.f};
                if (bias) b0 = *(const f32x4*)(bias + col);
#pragma unroll
                for (int ai = 0; ai < 2; ++ai)
#pragma unroll
                    for (int m = 0; m < 4; ++m) {
                        f32x4 v = acc[ai][bj][m][n] + b0;
#pragma unroll
                        for (int e = 0; e < 4; ++e) v[e] = __builtin_amdgcn_exp2f(-0.8750387749145276f * fsigmoid(v[e]));
                        *(f32x4*)(O + (size_t)(row0 + ai * HALF + m * 16) * ldc + col) = v;
                    }
            }
    }
};
struct EpiResid {
    static constexpr bool PERM = false, AFTER_DRAIN = false;
    const float* base; float* out; const float* gate; int gstride; float coef;
    __device__ __forceinline__ void operator()(const f32x4 (&acc)[2][2][4][2], const Unit& u, int, int, int, int) const {
        const int t2 = mk_tid(), wr = t2 >> 8, wc = (t2 >> 6) & 3, fr = t2 & 15, fq = (t2 >> 4) & 3;
        const int row0 = u.pm * BM + wr * 64 + fr;
        const float* gb = gate + (size_t)((u.pm * BM) >> 13) * gstride;
#pragma unroll
        for (int bj = 0; bj < 2; ++bj)
#pragma unroll
            for (int n = 0; n < 2; ++n) {
                const int col = u.pn * BM + bj * HALF + wc * 32 + 16 * n + 4 * fq;
                const f32x4 gv = *(const f32x4*)(gb + col) * coef;
#pragma unroll
                for (int ai = 0; ai < 2; ++ai)
#pragma unroll
                    for (int m = 0; m < 4; ++m) {
                        const size_t off = (size_t)(row0 + ai * HALF + m * 16) * 1024 + col;
                        const f32x4 bs = *(const f32x4*)(base + off);
                        *(f32x4*)(out + off) = bs + gv * acc[ai][bj][m][n];
                    }
            }
    }
};
struct EpiSwiglu {
    static constexpr bool PERM = true, AFTER_DRAIN = false;
    bf16_t* O; int ldc;
    __device__ __forceinline__ void operator()(const f32x4 (&acc)[2][2][4][2], const Unit& u, int, int, int, int) const {
        const int t2 = mk_tid(), wr = t2 >> 8, wc = (t2 >> 6) & 3, fr = t2 & 15, fq = (t2 >> 4) & 3;
        const int row0 = u.pm * BM + wr * 64 + fr;
        const int colb = u.pn * HALF + wc * 32 + 8 * fq;
#pragma unroll
        for (int ai = 0; ai < 2; ++ai)
#pragma unroll
            for (int m = 0; m < 4; ++m) {
                f32x4 g0 = acc[ai][0][m][0], g1 = acc[ai][0][m][1];
                const f32x4 u0 = acc[ai][1][m][0], u1 = acc[ai][1][m][1];
#pragma unroll
                for (int e = 0; e < 4; ++e) { g0[e] = g0[e] * fsigmoid(g0[e]) * u0[e]; g1[e] = g1[e] * fsigmoid(g1[e]) * u1[e]; }
                u32x4 w; w.x = cvt_pk_bf16(g0[0], g0[1]); w.y = cvt_pk_bf16(g0[2], g0[3]); w.z = cvt_pk_bf16(g1[0], g1[1]); w.w = cvt_pk_bf16(g1[2], g1[3]);
                *(u32x4*)(O + (size_t)(row0 + ai * HALF + m * 16) * ldc + colb) = w;
            }
    }
};

template <class Epi, class Sched, bool ALIGN_EPI = false, bool SP2 = false>
__device__ __forceinline__ void gemm_phase(PG8_LAS unsigned char* lds, const Gemm g, const Sched& S, const Epi& E) {
    const int tid = mk_tid(), wid = __builtin_amdgcn_readfirstlane(tid >> 6), lane = tid & 63, wr = wid >> 2, wc = wid & 3, fr = lane & 15, fq = lane >> 4;
    const int K = g.K, nt = K / BK;
    unsigned voffA[2], voffB[2];
#pragma unroll
    for (int i = 0; i < 2; ++i) { int R, C; stage_rc(tid * 16 + i * 8192, R, C); const int Rb = Epi::PERM ? ((R & ~31) + perm32(R & 31)) : R;
        voffA[i] = (unsigned)(R * K + C) * 2u; voffB[i] = (unsigned)(Rb * K + C) * 2u; }
    const size_t kstep = (size_t)(BK * 2);
    const size_t hstep = (size_t)HALF * K * 2;
    const size_t tstep = 2 * hstep;
    const unsigned ldsw = (unsigned)wid * 1024u;
    const int aoff = lds_byte(wr * 64 + fr, fq * 8), boff = lds_byte(wc * 32 + fr, fq * 8);
#define PG8_SA(b, h) (((b) * 2 + (h)) * HTB)
#define PG8_SB(b, h) ((4 + (b) * 2 + (h)) * HTB)
#define PG8_STAGE(bufoff, gbase, voff) do { _Pragma("unroll") for (int _i = 0; _i < 2; ++_i) \
        __builtin_amdgcn_global_load_lds((const unsigned*)((const char*)(gbase) + (voff)[_i]), (PG8_LAS unsigned*)(lds + (bufoff) + ldsw + _i * 8192), 16, 0, 0); } while (0)
#define PG8_LDA(dst, b, h) do { _Pragma("unroll") for (int m = 0; m < 4; ++m) _Pragma("unroll") for (int k = 0; k < 2; ++k) dst[m][k] = *(const PG8_LAS bf16x8*)(lds + PG8_SA(b, h) + aoff + m * 2048 + k * 1024); } while (0)
#define PG8_LDB(dst, b, h) do { _Pragma("unroll") for (int n = 0; n < 2; ++n) _Pragma("unroll") for (int k = 0; k < 2; ++k) dst[n][k] = *(const PG8_LAS bf16x8*)(lds + PG8_SB(b, h) + boff + n * 2048 + k * 1024); } while (0)
#define PG8_MMA(ai, bj, At, Bt) do { __builtin_amdgcn_s_setprio(1); _Pragma("unroll") for (int m = 0; m < 4; ++m) _Pragma("unroll") for (int n = 0; n < 2; ++n) _Pragma("unroll") for (int k = 0; k < 2; ++k) \
        acc[ai][bj][m][n] = __builtin_amdgcn_mfma_f32_16x16x32_bf16(Bt[n][k], At[m][k], acc[ai][bj][m][n], 0, 0, 0); __builtin_amdgcn_s_setprio(0); } while (0)
#define PG8_WAIT_V(n) asm volatile("s_waitcnt vmcnt(" #n ")" ::: "memory")
#define PG8_WAIT_L(n) asm volatile("s_waitcnt lgkmcnt(" #n ")" ::: "memory")
#define PG8_BAR __builtin_amdgcn_s_barrier()
#define PG8_SCHED __builtin_amdgcn_sched_barrier(0)
    Unit cur, nxt; int ui = 0;
    if (!S.next(0, cur)) return;
    f32x4 acc[2][2][4][2];
#pragma unroll
    for (int a = 0; a < 2; ++a)
#pragma unroll
        for (int b = 0; b < 2; ++b)
#pragma unroll
            for (int m = 0; m < 4; ++m)
#pragma unroll
                for (int n = 0; n < 2; ++n) acc[a][b][m][n] = (f32x4){0.f, 0.f, 0.f, 0.f};
    bf16x8 At[4][2], B0[2][2], B1[2][2];
    const char* cA = (const char*)g.A + (size_t)cur.pm * tstep; const char* cB = (const char*)g.Bt + (size_t)cur.pn * tstep;
    S.a_ready(cur);
    if constexpr (SP2) {
        PG8_STAGE(PG8_SB(0, 0), cB, voffB); PG8_STAGE(PG8_SB(0, 1), cB + hstep, voffB); PG8_STAGE(PG8_SA(0, 0), cA, voffA); PG8_STAGE(PG8_SA(0, 1), cA + hstep, voffA);
        if (wr == 1) PG8_BAR;
        PG8_WAIT_V(2); PG8_BAR;
        PG8_STAGE(PG8_SB(1, 0), cB + kstep, voffB); PG8_STAGE(PG8_SA(1, 0), cA + kstep, voffA); PG8_STAGE(PG8_SB(1, 1), cB + hstep + kstep, voffB);
        PG8_WAIT_V(6); PG8_BAR;
    } else {
        PG8_STAGE(PG8_SB(0, 0), cB, voffB); PG8_STAGE(PG8_SA(0, 0), cA, voffA); PG8_STAGE(PG8_SB(0, 1), cB + hstep, voffB); PG8_STAGE(PG8_SA(0, 1), cA + hstep, voffA);
        if (wr == 1) PG8_BAR;
        PG8_WAIT_V(4); PG8_BAR;
        PG8_STAGE(PG8_SB(1, 0), cB + kstep, voffB); PG8_STAGE(PG8_SA(1, 0), cA + kstep, voffA); PG8_STAGE(PG8_SB(1, 1), cB + hstep + kstep, voffB);
        PG8_WAIT_V(6); PG8_BAR;
    }
    for (;;) {
        const bool has_next = S.next(ui + 1, nxt);
        const char* nA = has_next ? (const char*)g.A + (size_t)nxt.pm * tstep : cA; const char* nB = has_next ? (const char*)g.Bt + (size_t)nxt.pn * tstep : cB;
        for (int t = 0; t < nt; t += 2) {
            const bool last = (t == nt - 2);
            const char* a1 = cA + (size_t)(t + 1) * kstep;
            const char* a2 = last ? nA : cA + (size_t)(t + 2) * kstep; const char* b2 = last ? nB : cB + (size_t)(t + 2) * kstep;
            const char* a3 = a2 + kstep; const char* b3 = b2 + kstep;
            if (last && has_next) S.a_ready(nxt);
            if constexpr (SP2) {
            PG8_LDB(B0, 0, 0); PG8_LDB(B1, 0, 1); PG8_SCHED; PG8_LDA(At, 0, 0); PG8_STAGE(PG8_SA(1, 1), a1 + hstep, voffA);
            PG8_WAIT_V(8); PG8_WAIT_L(0); PG8_BAR; PG8_MMA(0, 0, At, B0); PG8_MMA(0, 1, At, B1); PG8_BAR; PG8_SCHED;
            PG8_LDA(At, 0, 1); PG8_STAGE(PG8_SB(0, 0), b2, voffB); PG8_STAGE(PG8_SB(0, 1), b2 + hstep, voffB); PG8_STAGE(PG8_SA(0, 0), a2, voffA);
            PG8_WAIT_V(8); PG8_WAIT_L(0); PG8_BAR; PG8_MMA(1, 0, At, B0); PG8_MMA(1, 1, At, B1); PG8_BAR; PG8_SCHED;
            PG8_LDB(B0, 1, 0); PG8_LDB(B1, 1, 1); PG8_SCHED; PG8_LDA(At, 1, 0); PG8_STAGE(PG8_SA(0, 1), a2 + hstep, voffA);
            PG8_WAIT_V(8); PG8_WAIT_L(0); PG8_BAR; PG8_MMA(0, 0, At, B0); PG8_MMA(0, 1, At, B1); PG8_BAR; PG8_SCHED;
            PG8_LDA(At, 1, 1); PG8_STAGE(PG8_SB(1, 0), b3, voffB); PG8_STAGE(PG8_SB(1, 1), b3 + hstep, voffB); PG8_STAGE(PG8_SA(1, 0), a3, voffA);
            PG8_WAIT_V(8); PG8_WAIT_L(0); PG8_BAR; PG8_MMA(1, 0, At, B0); PG8_MMA(1, 1, At, B1); PG8_BAR; PG8_SCHED;
            } else {
            PG8_LDB(B0, 0, 0); PG8_SCHED; PG8_LDA(At, 0, 0); PG8_STAGE(PG8_SA(1, 1), a1 + hstep, voffA);
            PG8_WAIT_L(8); PG8_BAR; PG8_WAIT_L(0); PG8_MMA(0, 0, At, B0); PG8_BAR; PG8_SCHED;
            PG8_LDB(B1, 0, 1); PG8_STAGE(PG8_SB(0, 0), b2, voffB);
            PG8_BAR; PG8_WAIT_L(0); PG8_MMA(0, 1, At, B1); PG8_BAR;
            PG8_LDA(At, 0, 1); PG8_STAGE(PG8_SA(0, 0), a2, voffA);
            PG8_BAR; PG8_WAIT_L(0); PG8_MMA(1, 0, At, B0); PG8_BAR; PG8_SCHED;
            PG8_STAGE(PG8_SB(0, 1), b2 + hstep, voffB);
            PG8_WAIT_V(6); PG8_BAR; PG8_MMA(1, 1, At, B1); PG8_BAR;
            PG8_LDB(B0, 1, 0); PG8_SCHED; PG8_LDA(At, 1, 0); PG8_STAGE(PG8_SA(0, 1), a2 + hstep, voffA);
            PG8_WAIT_L(8); PG8_BAR; PG8_WAIT_L(0); PG8_MMA(0, 0, At, B0); PG8_BAR; PG8_SCHED;
            PG8_LDB(B1, 1, 1); PG8_STAGE(PG8_SB(1, 0), b3, voffB);
            PG8_BAR; PG8_WAIT_L(0); PG8_MMA(0, 1, At, B1); PG8_BAR;
            PG8_LDA(At, 1, 1); PG8_STAGE(PG8_SA(1, 0), a3, voffA);
            PG8_BAR; PG8_WAIT_L(0); PG8_MMA(1, 0, At, B0); PG8_BAR; PG8_SCHED;
            PG8_STAGE(PG8_SB(1, 1), b3 + hstep, voffB);
            PG8_WAIT_V(6); PG8_BAR; PG8_MMA(1, 1, At, B1); PG8_BAR;
            }
        }
        if constexpr (ALIGN_EPI) { if (wr == 0) PG8_BAR; }
        if constexpr (!Epi::AFTER_DRAIN) { E(acc, cur, wr, wc, fr, fq); S.done(cur); }
        if (!has_next) break;
#pragma unroll
        for (int a = 0; a < 2; ++a)
#pragma unroll
            for (int b = 0; b < 2; ++b)
#pragma unroll
                for (int m = 0; m < 4; ++m)
#pragma unroll
                    for (int n = 0; n < 2; ++n) acc[a][b][m][n] = (f32x4){0.f, 0.f, 0.f, 0.f};
        cur = nxt; cA = nA; cB = nB; ++ui;
        if constexpr (ALIGN_EPI) { if (wr == 1) PG8_BAR; }
    }
    PG8_WAIT_V(0);
    if constexpr (!ALIGN_EPI) { if (wr == 0) PG8_BAR; }
    PG8_BAR;
    if constexpr (Epi::AFTER_DRAIN) { E.fused(acc, cur, wr, wc, fr, fq, lds, wid, lane); S.done(cur); }
#undef PG8_SA
#undef PG8_SB
#undef PG8_STAGE
#undef PG8_LDA
#undef PG8_LDB
#undef PG8_MMA
#undef PG8_WAIT_V
#undef PG8_WAIT_L
#undef PG8_BAR
#undef PG8_SCHED
}
}

namespace att {
using bf16 = __hip_bfloat16;
constexpr int   D = 128, NW = 8, QBLK = 32, KVBLK = 64;
constexpr float SCALE = 0.088388347648318440f;
constexpr float THR = 8.f;
constexpr int SDEPTH = 1;
constexpr int LDQ = 1536, LDK = 1536, LDO = 1024;
constexpr size_t SHM_V = KVBLK * D * 2, SHM_K = KVBLK * D * 2, SHM_ATTN = 2 * SHM_V + 2 * SHM_K + NW * 64 * 4;
using bf16x8 = __attribute__((ext_vector_type(8))) short;
using s16x4  = __attribute__((ext_vector_type(4))) short;
using f32x16 = __attribute__((ext_vector_type(16))) float;
using f32x8  = __attribute__((ext_vector_type(8))) float;
using u32x4  = __attribute__((ext_vector_type(4))) unsigned;
#define KSWZ(row, colB) ((row) * 256 + ((colB) ^ (((row) & 7) << 4)))
#define SBAR() __builtin_amdgcn_sched_barrier(0)
__device__ __forceinline__ int crow(int r, int hi) { return (r & 3) + 8 * (r >> 2) + 4 * hi; }
__device__ __forceinline__ unsigned cvtpk(float lo, float hi) {
  unsigned r; asm volatile("v_cvt_pk_bf16_f32 %0, %1, %2" : "=v"(r) : "v"(lo), "v"(hi)); return r;
}
template <typename TIn> struct Stage;
template <> struct Stage<bf16>  { using T = bf16x8;
  __device__ static __forceinline__ T ld8(const bf16* p) { return *reinterpret_cast<const bf16x8*>(p); }
  __device__ static __forceinline__ bf16x8 tobf(T x) { return x; } };
template <> struct Stage<float> { using T = f32x8;
  __device__ static __forceinline__ T ld8(const float* p) { return *reinterpret_cast<const f32x8*>(p); }
  __device__ static __forceinline__ bf16x8 tobf(T x) {
    u32x4 w = {cvtpk(x[0], x[1]), cvtpk(x[2], x[3]), cvtpk(x[4], x[5]), cvtpk(x[6], x[7])}; return *reinterpret_cast<bf16x8*>(&w); } };

__device__ __forceinline__ void partialSM(f32x16& p0, f32x16& p1, float& m_reg, float& mn, float& alpha) {
  constexpr float C = SCALE * 1.4426950408889634f;
  float pmax = p0[0]; for (int r = 1; r < 16; ++r) pmax = fmaxf(pmax, p0[r]); for (int r = 0; r < 16; ++r) pmax = fmaxf(pmax, p1[r]);
  { auto rr = __builtin_amdgcn_permlane32_swap(__float_as_uint(pmax), __float_as_uint(pmax), false, false);
    pmax = fmaxf(__uint_as_float(rr[0]), __uint_as_float(rr[1])); }
  if (__builtin_expect(__all(pmax - m_reg <= THR / SCALE), 1)) { mn = m_reg; alpha = 1.f; }
  else { mn = fmaxf(m_reg, pmax); alpha = __builtin_amdgcn_exp2f((m_reg - mn) * C); m_reg = mn; }
  float mnC = -mn * C;
  for (int r = 0; r < 16; ++r) p0[r] = fmaf(p0[r], C, mnC); for (int r = 0; r < 16; ++r) p1[r] = fmaf(p1[r], C, mnC);
  for (int r = 0; r < 16; ++r) p0[r] = __builtin_amdgcn_exp2f(p0[r]);
}
__device__ __forceinline__ void finishSM(f32x16& p0, f32x16& p1, float alpha, float& l_reg, bf16x8& pa0, bf16x8& pa1, bf16x8& pa2, bf16x8& pa3) {
  for (int r = 0; r < 16; ++r) p1[r] = __builtin_amdgcn_exp2f(p1[r]);
  float ps = 0; for (int r = 0; r < 16; ++r) ps += p0[r]; for (int r = 0; r < 16; ++r) ps += p1[r];
  { auto rr = __builtin_amdgcn_permlane32_swap(__float_as_uint(ps), __float_as_uint(ps), false, false);
    ps = __uint_as_float(rr[0]) + __uint_as_float(rr[1]); }
  l_reg = l_reg * alpha + ps;
#define PK4(P, BASE, OUT) do { unsigned a0 = cvtpk(P[BASE + 0], P[BASE + 1]), a1 = cvtpk(P[BASE + 2], P[BASE + 3]);   \
    unsigned b0 = cvtpk(P[BASE + 4], P[BASE + 5]), b1 = cvtpk(P[BASE + 6], P[BASE + 7]);                              \
    auto r0 = __builtin_amdgcn_permlane32_swap(a0, b0, false, false); auto r1 = __builtin_amdgcn_permlane32_swap(a1, b1, false, false); \
    u32x4 w = {r0[0], r1[0], r0[1], r1[1]}; OUT = *reinterpret_cast<bf16x8*>(&w); } while (0)
  PK4(p0, 0, pa0); PK4(p0, 8, pa1); PK4(p1, 0, pa2); PK4(p1, 8, pa3);
#undef PK4
}
__device__ __forceinline__ void qkt(f32x16& p0, f32x16& p1, const bf16* Ks, const bf16x8* qr, int r32, int hi) {
  p0 = f32x16{}; p1 = f32x16{};
  for (int d0 = 0; d0 < 8; ++d0) { int cb = (d0 * 16 + hi * 8) * 2;
    bf16x8 b0 = *reinterpret_cast<const bf16x8*>((const char*)Ks + KSWZ(r32, cb));
    bf16x8 b1 = *reinterpret_cast<const bf16x8*>((const char*)Ks + KSWZ(32 + r32, cb));
    p0 = __builtin_amdgcn_mfma_f32_32x32x16_bf16(b0, qr[d0], p0, 0, 0, 0);
    p1 = __builtin_amdgcn_mfma_f32_32x32x16_bf16(b1, qr[d0], p1, 0, 0, 0); }
}
__device__ __forceinline__ int v_st(int k, int c) { const int kk = (k & ~0xC) | ((k & 4) << 1) | ((k & 8) >> 1); return ((kk >> 3) * 4 + (c >> 5)) * 512 + ((kk & 7) * 32 + (c & 31)) * 2; }
__device__ __forceinline__ int v_rd_base(int lane) { return ((lane & 3) << 3) | (((lane >> 2) & 3) << 6) | (((lane >> 4) & 1) << 5) | (((lane >> 5) & 1) << 8); }
constexpr int v_rd_off(int d0, int ks, int half) { return d0 * 512 + ks * 4096 + half * 2048; }
template <int OFF> __device__ __forceinline__ s16x4 tr_read(int vb) {
  s16x4 r; asm volatile("ds_read_b64_tr_b16 %0, %1 offset:%2" : "=&v"(r) : "v"(vb), "i"(OFF) : "memory"); return r;
}
template <int D0> __device__ __forceinline__ void pv_one(f32x16& od, int vb, bf16x8 pa0, bf16x8 pa1, bf16x8 pa2, bf16x8 pa3) {
  const s16x4 l0 = tr_read<v_rd_off(D0, 0, 0)>(vb), h0 = tr_read<v_rd_off(D0, 0, 1)>(vb), l1 = tr_read<v_rd_off(D0, 1, 0)>(vb), h1 = tr_read<v_rd_off(D0, 1, 1)>(vb);
  const s16x4 l2 = tr_read<v_rd_off(D0, 2, 0)>(vb), h2 = tr_read<v_rd_off(D0, 2, 1)>(vb), l3 = tr_read<v_rd_off(D0, 3, 0)>(vb), h3 = tr_read<v_rd_off(D0, 3, 1)>(vb);
  asm volatile("s_waitcnt lgkmcnt(0)" ::: "memory"); SBAR();
#define PK(L, H) (bf16x8){L[0], L[1], L[2], L[3], H[0], H[1], H[2], H[3]}
  od = __builtin_amdgcn_mfma_f32_32x32x16_bf16(pa0, PK(l0, h0), od, 0, 0, 0);
  od = __builtin_amdgcn_mfma_f32_32x32x16_bf16(pa1, PK(l1, h1), od, 0, 0, 0);
  od = __builtin_amdgcn_mfma_f32_32x32x16_bf16(pa2, PK(l2, h2), od, 0, 0, 0);
  od = __builtin_amdgcn_mfma_f32_32x32x16_bf16(pa3, PK(l3, h3), od, 0, 0, 0);
#undef PK
}
__device__ __forceinline__ void pv_d0(f32x16* o, int vb, bf16x8 pa0, bf16x8 pa1, bf16x8 pa2, bf16x8 pa3) {
  pv_one<0>(o[0], vb, pa0, pa1, pa2, pa3); pv_one<1>(o[1], vb, pa0, pa1, pa2, pa3); pv_one<2>(o[2], vb, pa0, pa1, pa2, pa3); pv_one<3>(o[3], vb, pa0, pa1, pa2, pa3);
}

template <typename TQ>
__device__ __forceinline__ void attn_dense_body(const TQ* __restrict__ Qb, const bf16* __restrict__ Kh, const bf16* __restrict__ Vh,
                                                bf16* __restrict__ Ob, int seq, char* lds) {
  using St = Stage<bf16>; using SQ = Stage<TQ>;
  const int tid = mk_tid(), wid = tid >> 6, lane = tid & 63, r32 = lane & 31, hi = lane >> 5;
  bf16* V_lds = (bf16*)lds; bf16* K_lds = (bf16*)(lds + 2 * SHM_V);
  float* ws = (float*)(lds + 2 * SHM_V + 2 * SHM_K) + wid * 64; float* li_l = ws; float* al_l = ws + 32;
  float m_reg = -1e30f, l_reg = 0; f32x16 o[4] = {}; bf16x8 qr[8];
  const TQ* Qw = Qb + (long)(wid * QBLK + r32) * LDQ + hi * 8;
#pragma unroll
  for (int d0 = 0; d0 < 8; ++d0) qr[d0] = SQ::tobf(SQ::ld8(Qw + d0 * 16));
  const int sr = tid >> 4, sc = (tid & 15) * 8, vst0 = v_st(sr, sc), vst1 = v_st(32 + sr, sc);
  const int vb0 = (int)(uintptr_t)V_lds + v_rd_base(lane);
  struct { typename St::T vs0, vs1, ks0, ks1; } sr_[SDEPTH];
#define SLOAD(i, k0) do { sr_[i].vs0 = St::ld8(&Vh[(long)((k0) + sr) * LDK + sc]); sr_[i].vs1 = St::ld8(&Vh[(long)((k0) + 32 + sr) * LDK + sc]); \
    sr_[i].ks0 = St::ld8(&Kh[(long)((k0) + sr) * LDK + sc]); sr_[i].ks1 = St::ld8(&Kh[(long)((k0) + 32 + sr) * LDK + sc]); } while (0)
#define SWRITE(b, i) do { *(bf16x8*)((char*)V_lds + (b) * SHM_V + vst0) = St::tobf(sr_[i].vs0);          \
    *(bf16x8*)((char*)V_lds + (b) * SHM_V + vst1) = St::tobf(sr_[i].vs1); int kc = sc * 2;               \
    *(bf16x8*)((char*)K_lds + (b) * SHM_K + KSWZ(sr, kc)) = St::tobf(sr_[i].ks0);                       \
    *(bf16x8*)((char*)K_lds + (b) * SHM_K + KSWZ(32 + sr, kc)) = St::tobf(sr_[i].ks1); } while (0)
#define SWAIT() do { if constexpr (SDEPTH == 2) asm volatile("s_waitcnt vmcnt(4)" ::: "memory"); else asm volatile("s_waitcnt vmcnt(0)" ::: "memory"); } while (0)
#define RESC(a) do { if (__any((a) < 1.f)) { if (hi == 0) al_l[r32] = (a); asm volatile("s_waitcnt lgkmcnt(0)" ::: "memory"); \
    for (int d = 0; d < 4; ++d) for (int r = 0; r < 16; ++r) o[d][r] *= al_l[crow(r, hi)]; } } while (0)
  f32x16 pA0, pA1, pB0, pB1; float mnA, mnB, alA, alB; bf16x8 pa0, pa1, pa2, pa3; const int NT = seq / KVBLK;
  constexpr int SE = 0, SO = SDEPTH - 1;
  SLOAD(SE, 0); asm volatile("s_waitcnt vmcnt(0)" ::: "memory"); SWRITE(0, SE); __syncthreads();
  qkt(pA0, pA1, K_lds, qr, r32, hi); partialSM(pA0, pA1, m_reg, mnA, alA);
  SLOAD(SO, KVBLK); if constexpr (SDEPTH == 2) { if (2 < NT) SLOAD(SE, 2 * KVBLK); }
  SWAIT(); SWRITE(1, SO); __syncthreads();
  for (int j = 1; j + 1 < NT; j += 2) {
    SBAR(); qkt(pB0, pB1, (bf16*)((char*)K_lds + SHM_K), qr, r32, hi);
    finishSM(pA0, pA1, alA, l_reg, pa0, pa1, pa2, pa3); SBAR();
    SLOAD(SO, (j + SDEPTH) * KVBLK); SBAR();
    pv_d0(o, vb0, pa0, pa1, pa2, pa3); partialSM(pB0, pB1, m_reg, mnB, alB);
    __syncthreads(); SWAIT(); SWRITE(0, SE);
    RESC(alB); __syncthreads();
    SBAR(); qkt(pA0, pA1, K_lds, qr, r32, hi);
    finishSM(pB0, pB1, alB, l_reg, pa0, pa1, pa2, pa3); SBAR();
    if (SDEPTH == 1 || j + 3 < NT) SLOAD(SE, (j + 1 + SDEPTH) * KVBLK); SBAR();
    pv_d0(o, vb0 + (int)SHM_V, pa0, pa1, pa2, pa3); partialSM(pA0, pA1, m_reg, mnA, alA);
    __syncthreads(); SWAIT(); SWRITE(1, SO);
    RESC(alA); __syncthreads();
  }
  SBAR(); qkt(pB0, pB1, (bf16*)((char*)K_lds + SHM_K), qr, r32, hi);
  finishSM(pA0, pA1, alA, l_reg, pa0, pa1, pa2, pa3); SBAR();
  pv_d0(o, vb0, pa0, pa1, pa2, pa3); partialSM(pB0, pB1, m_reg, mnB, alB);
  __syncthreads(); RESC(alB);
  finishSM(pB0, pB1, alB, l_reg, pa0, pa1, pa2, pa3); SBAR();
  pv_d0(o, vb0 + (int)SHM_V, pa0, pa1, pa2, pa3);
  if (hi == 0) li_l[r32] = l_reg; asm volatile("s_waitcnt lgkmcnt(0)" ::: "memory");
  float rli[16];
#pragma unroll
  for (int r = 0; r < 16; ++r) rli[r] = __builtin_amdgcn_rcpf(li_l[crow(r, hi)]);
  unsigned short* Ow = (unsigned short*)Ob + (long)(wid * QBLK) * LDO;
#pragma unroll
  for (int r = 0; r < 16; ++r) { int orow = crow(r, hi);
    for (int d0 = 0; d0 < 4; ++d0) Ow[(long)orow * LDO + d0 * 32 + r32] = (unsigned short)(cvtpk(o[d0][r] * rli[r], 0.f) & 0xffffu); }
#undef SLOAD
#undef SWRITE
#undef SWAIT
#undef RESC
}
}

#define LAS __attribute__((address_space(3)))
typedef unsigned short bf16_t;
typedef float f32x4 __attribute__((ext_vector_type(4)));
typedef float f32x2 __attribute__((ext_vector_type(2)));
typedef unsigned u32x2 __attribute__((ext_vector_type(2)));
typedef unsigned u32x4 __attribute__((ext_vector_type(4)));

constexpr int BATCH = 2, SEQ = 8192, DM = 1024, TT = BATCH * SEQ, DFF = 2816, NQKV = 1536, DEPTH = 4;
constexpr int NTHR = 512, NWAVES = 8;
constexpr int LDS_BYTES = 147456;
constexpr size_t MiB = 1u << 20, KiB = 1024;
constexpr size_t WS_W = 1 * MiB, WS_MOD = 46 * MiB, WS_VF = 47 * MiB, WS_H = 79 * MiB, WS_BIG = 111 * MiB, WS_END = 575 * MiB;
constexpr size_t W_F0G = 0, W_F0D = 11 * MiB, W_F1G = 16 * MiB + 512 * KiB, W_F1D = 27 * MiB + 512 * KiB, W_MX = 33 * MiB;
constexpr size_t MX_QKV = 0, MX_AWO = 3 * MiB;
constexpr size_t MX_WR = 0, MX_RWO = 6 * MiB, MX_L1 = 8 * MiB  , MX_L2W = 10 * MiB, MX_L2A = 10 * MiB + 512 * KiB, MX_L2G = 11 * MiB, MX_L2V = 11 * MiB + 256 * KiB;
constexpr size_t B_HID = 0, B_QKV = 0;
constexpr size_t B_MIX = 0  , B_R = 192 * MiB, B_K = 224 * MiB, B_V = 256 * MiB, B_L1 = 288 * MiB  , B_G = 304 * MiB, B_A = 336 * MiB, B_Y1 = 400 * MiB;
constexpr size_t B_DEC = 0, B_Y0 = 128 * MiB, B_POST = 0;

struct Params { const float* in[34]; int ph_lo, ph_hi; };

__device__ __forceinline__ unsigned pk2(float lo, float hi) { return pg8::cvt_pk_bf16(lo, hi); }
__device__ __forceinline__ float bflo(unsigned w) { return __uint_as_float(w << 16); }
__device__ __forceinline__ float bfhi(unsigned w) { return __uint_as_float(w & 0xffff0000u); }
__device__ __forceinline__ f32x4 ld_bf4(const bf16_t* p) { const u32x2 w = *(const u32x2*)p; return (f32x4){bflo(w.x), bfhi(w.x), bflo(w.y), bfhi(w.y)}; }
__device__ __forceinline__ f32x4 un_bf4(u32x2 w) { return (f32x4){bflo(w.x), bfhi(w.x), bflo(w.y), bfhi(w.y)}; }
__device__ __forceinline__ void st_bf4(bf16_t* p, f32x4 v) { u32x2 w; w.x = pk2(v.x, v.y); w.y = pk2(v.z, v.w); *(u32x2*)p = w; }
__device__ __forceinline__ float wave_sum(float v) {
#pragma unroll
    for (int o = 1; o < 64; o <<= 1) v += __shfl_xor(v, o);
    return v;
}
__device__ __forceinline__ float sum16(float v) {
#pragma unroll
    for (int o = 1; o < 16; o <<= 1) v += __shfl_xor(v, o);
    return v;
}
__device__ __forceinline__ float dot4(f32x4 a, f32x4 b) { return (a.x * b.x + a.y * b.y) + (a.z * b.z + a.w * b.w); }
template <int CTRL> __device__ __forceinline__ float dpp_mov(float v) { return __int_as_float(__builtin_amdgcn_update_dpp(0, __float_as_int(v), CTRL, 0xf, 0xf, false)); }
__device__ __forceinline__ float row_sum16(float p) {
    p += dpp_mov<0xB1>(p); p += dpp_mov<0x4E>(p); p += dpp_mov<0x141>(p); p += dpp_mov<0x140>(p); return p;
}
#define LDS_WAIT() asm volatile("s_waitcnt lgkmcnt(0)" ::: "memory")

#define XB_TMO      128
#define XB_XCNT(j)  (256  + 64 * (j))
#define XB_XSUB(j)  (1280 + 64 * (j))
#define XB_XGEN(j)  (2304 + 64 * (j))
#define XB_TOP      3328
#define XB_TOPGEN   3392
#define XCD_BAR_WORDS 3456
#define XB_SPIN_CAP (1u << 18)

__device__ __forceinline__ unsigned xb_ld(unsigned* p)              { return __hip_atomic_load(p, __ATOMIC_RELAXED, __HIP_MEMORY_SCOPE_AGENT); }
__device__ __forceinline__ unsigned xb_add(unsigned* p, unsigned v) { return __hip_atomic_fetch_add(p, v, __ATOMIC_RELAXED, __HIP_MEMORY_SCOPE_AGENT); }
__device__ __forceinline__ unsigned xb_xcc_id() { return (unsigned)__builtin_amdgcn_s_getreg((3 << 11) | 20) & 0xFu; }
#define XB_SPIN(cond, bar) do { unsigned _sp = 0; while (cond) { __builtin_amdgcn_s_sleep(1); \
    if ((++_sp & 255u) == 0u) { if (xb_ld(&(bar)[XB_TMO])) break; if (_sp > XB_SPIN_CAP) { atomicAdd(&(bar)[XB_TMO], 1u); break; } } } } while (0)

struct XcdBarrier {
    unsigned* bar; unsigned x;
    volatile LAS unsigned* st;
};

__device__ __forceinline__ XcdBarrier xcd_barrier_post(unsigned* bar, volatile LAS unsigned* st) {
    XcdBarrier b; b.bar = bar; b.x = xb_xcc_id(); b.st = st;
    if (threadIdx.x == 0) (void)xb_add(&bar[XB_XCNT(b.x)], 1u);
    return b;
}
__device__ __forceinline__ void xcd_barrier_complete(unsigned* bar, unsigned x, unsigned& nloc, unsigned& nx) {
    const unsigned G = gridDim.x * gridDim.y * gridDim.z;
    unsigned sum, cnt, mine, sp = 0u;
    for (;;) {
        sum = 0u; cnt = 0u; mine = 0u;
#pragma unroll
        for (unsigned j = 0; j < 16; ++j) { const unsigned c = xb_ld(&bar[XB_XCNT(j)]); sum += c; cnt += (c > 0u) ? 1u : 0u; mine = (j == x) ? c : mine; }
        if (sum == G) break;
        __builtin_amdgcn_s_sleep(1);
        if ((++sp & 255u) == 0u) { if (xb_ld(&bar[XB_TMO])) break; if (sp > XB_SPIN_CAP) { atomicAdd(&bar[XB_TMO], 1u); break; } }
    }
    nloc = mine > 0u ? mine : 1u; nx = cnt > 0u ? cnt : 1u;
}

__device__ __forceinline__ void xcd_barrier(const XcdBarrier& b) {
    asm volatile("s_waitcnt vmcnt(0)" ::: "memory");
    __syncthreads();
    if (threadIdx.x == 0) {
        unsigned* bar = b.bar;
        __builtin_amdgcn_s_waitcnt(0);
        unsigned nloc = b.st[0], nx = b.st[1];
        if (nloc == 0u) { xcd_barrier_complete(bar, b.x, nloc, nx); b.st[0] = nloc; b.st[1] = nx; }
        const unsigned old = xb_add(&bar[XB_XSUB(b.x)], 1u);
        const unsigned gen = old / nloc;
        if (old + 1u == (gen + 1u) * nloc) {
            __builtin_amdgcn_fence(__ATOMIC_RELEASE, "agent");
            asm volatile("s_waitcnt vmcnt(0)" ::: "memory");
            const unsigned og = xb_add(&bar[XB_TOP], 1u);
            const unsigned tg = og / nx;
            if (og + 1u == (tg + 1u) * nx) xb_add(&bar[XB_TOPGEN], 1u);
            else XB_SPIN(xb_ld(&bar[XB_TOPGEN]) == tg, bar);
            __builtin_amdgcn_fence(__ATOMIC_ACQUIRE, "agent");
            xb_add(&bar[XB_XGEN(b.x)], 1u);
            asm volatile("s_waitcnt vmcnt(0)" ::: "memory");
        } else {
            XB_SPIN(xb_ld(&bar[XB_XGEN(b.x)]) == gen, bar);
            __builtin_amdgcn_fence(__ATOMIC_ACQUIRE, "agent");
            asm volatile("s_waitcnt vmcnt(0)" ::: "memory");
        }
    }
    __syncthreads();
}


__device__ __forceinline__ void transpose_item(const float* W, int K, int N, bf16_t* WT, int mode, LAS float* scr, int item, int lane) {
    const int nblk = N / 32, kb = item / nblk, nb = item % nblk, k0 = 64 * kb, n0 = 32 * nb;
    const int drow0 = (mode == 0) ? n0 : ((n0 >> 7) * 256 + (n0 & 127) + (mode == 2 ? 128 : 0));
#pragma unroll 8
    for (int i = 0; i < 32; ++i) { const int kk = 2 * i + (lane >> 5); scr[kk * 33 + (lane & 31)] = W[(size_t)(k0 + kk) * N + n0 + (lane & 31)]; }
    LDS_WAIT();
    const int c = lane & 7;
#pragma unroll
    for (int j = 0; j < 4; ++j) { const int n = (lane >> 3) + 8 * j; const LAS float* s = scr + (8 * c) * 33 + n;
        u32x4 o; o.x = pk2(s[0 * 33], s[1 * 33]); o.y = pk2(s[2 * 33], s[3 * 33]); o.z = pk2(s[4 * 33], s[5 * 33]); o.w = pk2(s[6 * 33], s[7 * 33]);
        *(u32x4*)(WT + (size_t)(drow0 + n) * K + k0 + 8 * c) = o; }
    LDS_WAIT();
}
struct TJob { const float* src; bf16_t* dst; int K, N, mode, nitems; };
__device__ __forceinline__ TJob get_job(const Params& P, int z, unsigned char* ws, int L, int jb) {
    TJob j; unsigned char* wb = ws + WS_W; const int jm = L >> 1; const bool attn = !(L & 1);
    if (jb < 6) {
        const int f = jb / 3, q = jb % 3; const size_t wo = (size_t)(L * 2 + f) * DM * DFF;
        if (q == 0)      { j.src = P.in[5 + z] + wo; j.K = DM; j.N = DFF; j.mode = 1; j.dst = (bf16_t*)(wb + (f ? W_F1G : W_F0G)); }
        else if (q == 1) { j.src = P.in[6 + z] + wo; j.K = DM; j.N = DFF; j.mode = 2; j.dst = (bf16_t*)(wb + (f ? W_F1G : W_F0G)); }
        else             { j.src = P.in[7 + z] + wo; j.K = DFF; j.N = DM; j.mode = 0; j.dst = (bf16_t*)(wb + (f ? W_F1D : W_F0D)); }
    } else if (attn) {
        j.mode = 0; j.K = DM;
        if (jb == 6) { j.src = P.in[8 + z] + (size_t)jm * DM * NQKV; j.N = NQKV; j.dst = (bf16_t*)(wb + W_MX + MX_QKV); }
        else         { j.src = P.in[11 + z] + (size_t)jm * DM * DM; j.N = DM; j.dst = (bf16_t*)(wb + W_MX + MX_AWO); }
    } else {
        j.mode = 0; j.K = DM; j.N = DM;
        if (jb < 9) { j.src = P.in[13 + z] + (size_t)(jm * 3 + (jb - 6)) * DM * DM; j.dst = (bf16_t*)(wb + W_MX + MX_WR + (size_t)(jb - 6) * 2 * MiB); }
        else        { j.src = P.in[27 + z] + (size_t)jm * DM * DM; j.dst = (bf16_t*)(wb + W_MX + MX_RWO); }
    }
    j.nitems = (j.K / 64) * (j.N / 32);
    return j;
}
__device__ __forceinline__ void fill_l1(bf16_t* dst, const float* src, int nsrc, int rank, int gtid, int gthreads) {
    for (int i = gtid; i < 256 * 512; i += gthreads) { const int n = i >> 9, k = (i & 511) * 2; float a = 0.f, b = 0.f;
        if (n < nsrc * rank) { const float* s = src + (size_t)(n / rank) * 1024 * rank + (n % rank); a = s[(size_t)k * rank]; b = s[(size_t)(k + 1) * rank]; }
        ((unsigned*)dst)[i] = pk2(a, b); }
}
__device__ __forceinline__ void fill_l2bd(bf16_t* dst, const float* src, int gtid, int gthreads) {
    for (int i = gtid; i < 2048 * 64; i += gthreads) { const int n = i >> 6, k = (i & 63) * 2, dir = n >> 10, col = n & 1023, kk = k - 64 * dir; float a = 0.f, b = 0.f;
        if (kk >= 0 && kk < 64) { a = src[(size_t)(dir * 64 + kk) * 1024 + col]; b = src[(size_t)(dir * 64 + kk + 1) * 1024 + col]; }
        ((unsigned*)dst)[i] = pk2(a, b); }
}
__device__ __forceinline__ void fill_l2(bf16_t* dst, const float* src, int rank, int gtid, int gthreads) {
    for (int i = gtid; i < 1024 * 64; i += gthreads) { const int n = i >> 6, k = (i & 63) * 2; float a = 0.f, b = 0.f;
        if (k < rank) { a = src[(size_t)k * 1024 + n]; b = src[(size_t)(k + 1) * 1024 + n]; }
        ((unsigned*)dst)[i] = pk2(a, b); }
}
__device__ __forceinline__ void mods_phase(const Params& P, int z, unsigned char* ws, LAS unsigned char* lds, int tid) {
    LAS float* cs = (LAS float*)lds;
    LAS float* red = cs + 2048;
    float* MOD = (float*)(ws + WS_MOD);
    for (int i = tid; i < 2048; i += NTHR) { const float c = P.in[1 + z][i]; cs[i] = c * pg8::fsigmoid(c); }
    __syncthreads();
    const int cgi = tid & 31, dp = tid >> 5;
    for (int item = blockIdx.x; item < 4 * 72; item += gridDim.x) {
        const int l = item / 72, cb = item % 72, col = cb * 128 + cgi * 4;
        const float* w = P.in[2 + z] + (size_t)l * DM * 9216 + (size_t)(dp * 64) * 9216 + col;
        f32x4 a0 = (f32x4){0.f, 0.f, 0.f, 0.f}, a1 = a0;
#pragma unroll 8
        for (int d = 0; d < 64; ++d) { const f32x4 wv = *(const f32x4*)(w + (size_t)d * 9216); const float c0 = cs[dp * 64 + d], c1 = cs[1024 + dp * 64 + d]; a0 += wv * c0; a1 += wv * c1; }
        *(LAS f32x4*)(red + (dp * 32 + cgi) * 8) = a0; *(LAS f32x4*)(red + (dp * 32 + cgi) * 8 + 4) = a1;
        __syncthreads();
        if (tid < 256) { const int ci = tid >> 3, e = tid & 7; float s = 0.f;
#pragma unroll
            for (int p = 0; p < 16; ++p) s += red[(p * 32 + ci) * 8 + e];
            const int b = e >> 2, cc = cb * 128 + ci * 4 + (e & 3);
            MOD[(size_t)(l * 2 + b) * 9216 + cc] = s + P.in[3 + z][(size_t)l * 9216 + cc]; }
        __syncthreads();
    }
}
__device__ __forceinline__ const float* mod_vec(unsigned char* ws, int L, int j) { return (const float*)(ws + WS_MOD) + (size_t)(L * 2) * 9216 + (size_t)j * 1024; }

__device__ __forceinline__ void norm_phase(const float* x, bf16_t* H, const float* g, const float* sh, const float* sc, int gw, int ngw, int lane) {
    for (int m = gw; m < TT; m += ngw) {
        const int b = m >> 13; const float* xr = x + (size_t)m * DM + 4 * lane;
        f32x4 v[4]; float ss = 0.f;
#pragma unroll
        for (int j = 0; j < 4; ++j) { v[j] = *(const f32x4*)(xr + 256 * j); ss += dot4(v[j], v[j]); }
        const float rstd = 1.0f / sqrtf(wave_sum(ss) * (1.0f / DM) + 1e-6f);
#pragma unroll
        for (int j = 0; j < 4; ++j) { const int c = 4 * lane + 256 * j;
            const f32x4 gv = *(const f32x4*)(g + c), scv = *(const f32x4*)(sc + b * 9216 + c), shv = *(const f32x4*)(sh + b * 9216 + c);
            st_bf4(H + (size_t)m * DM + c, v[j] * rstd * gv * (1.0f + scv) + shv); }
    }
}
__device__ __forceinline__ void final_norm_phase(float* x, const float* g, int gw, int ngw, int lane) {
    for (int m = gw; m < TT; m += ngw) {
        float* xr = x + (size_t)m * DM + 4 * lane;
        f32x4 v[4]; float ss = 0.f;
#pragma unroll
        for (int j = 0; j < 4; ++j) { v[j] = *(const f32x4*)(xr + 256 * j); ss += dot4(v[j], v[j]); }
        const float rstd = 1.0f / sqrtf(wave_sum(ss) * (1.0f / DM) + 1e-6f);
#pragma unroll
        for (int j = 0; j < 4; ++j) { const f32x4 gv = *(const f32x4*)(g + 4 * lane + 256 * j); *(f32x4*)(xr + 256 * j) = v[j] * rstd * gv; }
    }
}
__device__ __forceinline__ void mix_phase(const float* x, bf16_t* MIX, const float* g, const float* sh, const float* sc, const float* mix, int gw, int ngw, int lane) {
    for (int m = gw; m < TT; m += ngw) {
        const int b = m >> 13, t = m & (SEQ - 1); const bool hp = t > 0, hn = t < SEQ - 1;
        const float* xr = x + (size_t)m * DM + 4 * lane;
        f32x4 vc[4], vp[4], vn[4]; float sc_ = 0.f, sp_ = 0.f, sn_ = 0.f;
#pragma unroll
        for (int j = 0; j < 4; ++j) {
            vc[j] = *(const f32x4*)(xr + 256 * j);
            vp[j] = hp ? *(const f32x4*)(xr - DM + 256 * j) : (f32x4){0.f, 0.f, 0.f, 0.f};
            vn[j] = hn ? *(const f32x4*)(xr + DM + 256 * j) : (f32x4){0.f, 0.f, 0.f, 0.f};
            sc_ += dot4(vc[j], vc[j]); sp_ += dot4(vp[j], vp[j]); sn_ += dot4(vn[j], vn[j]);
        }
        const float rc = 1.0f / sqrtf(wave_sum(sc_) * (1.0f / DM) + 1e-6f), rp = 1.0f / sqrtf(wave_sum(sp_) * (1.0f / DM) + 1e-6f), rn = 1.0f / sqrtf(wave_sum(sn_) * (1.0f / DM) + 1e-6f);
#pragma unroll
        for (int j = 0; j < 4; ++j) { const int c = 4 * lane + 256 * j;
            const f32x4 gv = *(const f32x4*)(g + c) * (1.0f + *(const f32x4*)(sc + b * 9216 + c)), shv = *(const f32x4*)(sh + b * 9216 + c);
            const f32x4 h = vc[j] * rc * gv + shv;
            const f32x4 p = hp ? vp[j] * rp * gv + shv : (f32x4){0.f, 0.f, 0.f, 0.f};
            const f32x4 n = hn ? vn[j] * rn * gv + shv : (f32x4){0.f, 0.f, 0.f, 0.f};
            const f32x4 xx = 0.5f * (p + n) - h;
#pragma unroll
            for (int q = 0; q < 6; ++q) { const f32x4 mv = *(const f32x4*)(mix + q * DM + c); st_bf4(MIX + (size_t)q * TT * DM + (size_t)m * DM + c, h + xx * mv); }
        }
    }
}
__device__ __forceinline__ void qkrope_phase(bf16_t* QKV, const float* qg, const float* kg, int gw, int ngw, int lane) {
    const int p = lane;
    const float invf = __builtin_amdgcn_exp2f(-(float)(p & 31) * 0.4152410118609203f);
    for (int it = gw; it < TT * 10; it += ngw) {
        const int m = it / 10, hd = it - m * 10, t = m & (SEQ - 1);
        unsigned* ptr = (unsigned*)(QKV + (size_t)m * NQKV + hd * 128) + p;
        const unsigned w = *ptr; const float x0 = bflo(w), x1 = bfhi(w);
        const float rstd = 1.0f / sqrtf(wave_sum(x0 * x0 + x1 * x1) * (1.0f / 128.0f) + 1e-6f);
        const float* gn = hd < 8 ? qg : kg;
        const float y0 = x0 * rstd * gn[2 * p], y1 = x1 * rstd * gn[2 * p + 1];
        const float pos = (p < 32) ? (float)((t >> 6) - 64) : (float)((t & 63) - 32);
        float rev = pos * invf * 0.15915494309189535f; rev -= rintf(rev);
        const float s = __builtin_amdgcn_sinf(rev), c = __builtin_amdgcn_cosf(rev);
        *ptr = pk2(y0 * c - y1 * s, y0 * s + y1 * c);
    }
}
struct PostIn { const float *Y0, *Y1; const bf16_t *R, *K, *V, *A, *G, *VF, *VG; const float *k_a, *r_k, *ln_w, *ln_b; bf16_t* O; int has_vres; };
__device__ __forceinline__ void post_phase(const PostIn& I, int gw, int ngw, int lane) {
    for (int m = gw; m < TT; m += ngw) {
#pragma unroll
        for (int j = 0; j < 4; ++j) { const int c = 4 * lane + 256 * j; const size_t o = (size_t)m * DM + c;
            const f32x4 y = *(const f32x4*)(I.Y0 + o) + *(const f32x4*)(I.Y1 + o);
            const float mu = sum16((y.x + y.y) + (y.z + y.w)) * (1.0f / 64.0f);
            const f32x4 d = y - mu;
            const float var = sum16(dot4(d, d)) * (1.0f / 64.0f);
            const float rs = 1.0f / sqrtf(var + 64e-5f);
            const f32x4 r = ld_bf4(I.R + o), k = ld_bf4(I.K + o); f32x4 v = ld_bf4(I.V + o);
            const f32x4 a0 = ld_bf4(I.A + (size_t)m * 2048 + c), a1 = ld_bf4(I.A + (size_t)m * 2048 + 1024 + c);
            const f32x4 ka = *(const f32x4*)(I.k_a + c), rk = *(const f32x4*)(I.r_k + c);
            if (I.has_vres) { const f32x4 vf = ld_bf4(I.VF + o), vg = ld_bf4(I.VG + o); v = v + (vf - v) * vg; }
            const f32x4 kd = k * (1.0f + (a0 - 1.0f) * ka) + k * (1.0f + (a1 - 1.0f) * ka);
            const float bonus = sum16(dot4(r * kd, rk));
            const f32x4 lw = *(const f32x4*)(I.ln_w + c), lb = *(const f32x4*)(I.ln_b + c), gg = ld_bf4(I.G + o);
            st_bf4(I.O + o, (d * rs * lw + lb + bonus * v) * gg);
        }
    }
}
constexpr int TC = 32, SC_ARR = TC * 64 * 4, SC_BUF = 5 * SC_ARR + 2 * TC * 16 * 4;
struct ScanIn { const bf16_t *R, *K, *V, *A, *VF, *VG; const float* DEC; float *Y0, *Y1; const float *k_k, *k_a; int has_vres; };
struct ScanRegs { u32x2 r, k, v, a, vf, vg; f32x4 dec; };
__device__ __forceinline__ void scan_load(const ScanIn& I, ScanRegs (&rg)[2], int c, int st, int dir, int b, int h, int rq) {
#pragma unroll
    for (int i = 0; i < 2; ++i) { const int item = st + 256 * i, tl = item >> 4, c4 = (item & 15) * 4, ts = c * TC + tl, ta = dir ? SEQ - 1 - ts : ts;
        const size_t grow = (size_t)b * SEQ + ta, o = grow * DM + h * 64 + c4, o2 = grow * 2048 + dir * 1024 + h * 64 + c4;
        rg[i].r = *(const u32x2*)(I.R + o); rg[i].k = *(const u32x2*)(I.K + o); rg[i].v = *(const u32x2*)(I.V + o);
        rg[i].a = *(const u32x2*)(I.A + o2); rg[i].dec = *(const f32x4*)(I.DEC + o2);
        if (I.has_vres && (c4 >> 4) == rq) { rg[i].vf = *(const u32x2*)(I.VF + o); rg[i].vg = *(const u32x2*)(I.VG + o); } }
}
__device__ __forceinline__ void scan_stage(const ScanIn& I, const ScanRegs (&rg)[2], LAS unsigned char* buf, int st, int rq, f32x4 kkv, f32x4 kav) {
#pragma unroll
    for (int i = 0; i < 2; ++i) { const int item = st + 256 * i, tl = item >> 4, c4 = (item & 15) * 4;
        const f32x4 k = un_bf4(rg[i].k), a = un_bf4(rg[i].a), r = un_bf4(rg[i].r);
        const f32x4 kks = k * kkv; const float ss = sum16(dot4(kks, kks)); const float inv = 1.0f / fmaxf(sqrtf(ss), 1e-12f);
        const f32x4 kk = kks * inv, kd = k * (1.0f + (a - 1.0f) * kav), ka = kk * a;
        LAS f32x4* base = (LAS f32x4*)(buf + (tl * 64 + c4) * 4);
        base[0] = rg[i].dec; base[SC_ARR / 16] = kk; base[2 * SC_ARR / 16] = ka; base[3 * SC_ARR / 16] = kd; base[4 * SC_ARR / 16] = r;
        if ((c4 >> 4) == rq) { f32x4 v = un_bf4(rg[i].v); if (I.has_vres) { const f32x4 vf = un_bf4(rg[i].vf), vg = un_bf4(rg[i].vg); v = v + (vf - v) * vg; }
            *(LAS f32x4*)(buf + 5 * SC_ARR + (tl * 16 + (c4 & 15)) * 4) = v; } }
}
__device__ __forceinline__ void scan_writey(const ScanIn& I, const LAS unsigned char* buf, int c, int st, int dir, int b, int h, int rq) {
    const LAS float* yb = (const LAS float*)(buf + 5 * SC_ARR + TC * 16 * 4); float* Y = dir ? I.Y1 : I.Y0;
#pragma unroll
    for (int i = 0; i < 2; ++i) { const int item = st + 256 * i, tl = item >> 4, rl = item & 15, ts = c * TC + tl, ta = dir ? SEQ - 1 - ts : ts;
        Y[((size_t)b * SEQ + ta) * DM + h * 64 + rq * 16 + rl] = yb[item]; }
}
__device__ __forceinline__ void scan_unit(const ScanIn& I, LAS unsigned char* lds, int unit, int tid) {
    const int dir = unit >> 7, b = (unit >> 6) & 1, h = (unit >> 2) & 15, rq = unit & 3;
    constexpr int NC = SEQ / TC;
    const bool stager = tid >= 256; const int st = tid & 255;
    f32x4 s = (f32x4){0.f, 0.f, 0.f, 0.f};
    ScanRegs rg[2]; f32x4 kkv = s, kav = s;
    if (stager) { const int c4 = (st & 15) * 4; kkv = *(const f32x4*)(I.k_k + h * 64 + c4); kav = *(const f32x4*)(I.k_a + h * 64 + c4);
        scan_load(I, rg, 0, st, dir, b, h, rq); scan_stage(I, rg, lds, st, rq, kkv, kav); scan_load(I, rg, 1, st, dir, b, h, rq); }
    __syncthreads();
    for (int c = 0; c < NC; ++c) {
        LAS unsigned char* cur = lds + (c & 1) * SC_BUF; LAS unsigned char* nxt = lds + ((c + 1) & 1) * SC_BUF;
        if (stager) {
            if (c + 1 < NC) scan_stage(I, rg, nxt, st, rq, kkv, kav);
            if (c + 2 < NC) scan_load(I, rg, c + 2, st, dir, b, h, rq);
            if (c > 0) scan_writey(I, nxt, c - 1, st, dir, b, h, rq);
        } else {
            const int rl = tid >> 4, ks = tid & 15;
            const LAS f32x4* wq = (const LAS f32x4*)cur + ks; const LAS float* vb = (const LAS float*)(cur + 5 * SC_ARR) + rl; LAS float* yb = (LAS float*)(cur + 5 * SC_ARR + TC * 16 * 4) + rl;
#pragma unroll 4
            for (int tl = 0; tl < TC; ++tl) {
                const f32x4 w = wq[tl * 16], kk = wq[tl * 16 + SC_ARR / 16], ka = wq[tl * 16 + 2 * SC_ARR / 16], kd = wq[tl * 16 + 3 * SC_ARR / 16], r = wq[tl * 16 + 4 * SC_ARR / 16];
                const float vv = vb[tl * 16];
                const float sa = -row_sum16(dot4(s, kk));
                s = s * w + (sa * ka + vv * kd);
                const float y = row_sum16(dot4(s, r));
                if (ks == 0) yb[tl * 16] = y;
            }
        }
        __syncthreads();
    }
    if (stager) scan_writey(I, lds + ((NC - 1) & 1) * SC_BUF, NC - 1, st, dir, b, h, rq);
    __syncthreads();
}

#define MK_REP_ATT 1
#define MK_REP_SCAN 1
#define MK_REP_SYNC 1
#define MK_REP_SMALL 1
constexpr int PH_PER_LAYER = 13, NPHASES = DEPTH * PH_PER_LAYER + 1;

__global__ void __launch_bounds__(NTHR, 2) fwd_megakernel(Params P) {
    extern __shared__ __attribute__((aligned(16))) unsigned char lds_raw[];
    cg::grid_group grid = cg::this_grid();
    LAS unsigned char* lds = (LAS unsigned char*)lds_raw;

    volatile LAS unsigned* MISC = (volatile LAS unsigned*)(lds + LDS_BYTES - 64);
    if (threadIdx.x < 16) MISC[threadIdx.x] = 0u;
    __syncthreads();
    const XcdBarrier bar = xcd_barrier_post((unsigned*)P.in[33], MISC);
    for (int ph = P.ph_lo; ph < P.ph_hi; ++ph) {
        int z = 0; asm volatile("" : "+s"(z));
        unsigned char* ws = (unsigned char*)P.in[33 + z];
        float* X = (float*)P.in[32 + z];
        bf16_t* H = (bf16_t*)(ws + WS_H);
        unsigned char* wb = ws + WS_W; unsigned char* big = ws + WS_BIG;
        const int tid = mk_tid(), lane = tid & 63, wave = __builtin_amdgcn_readfirstlane(tid >> 6);
        const int gw = blockIdx.x * NWAVES + wave, ngw = gridDim.x * NWAVES, gtid = blockIdx.x * NTHR + tid, gthreads = gridDim.x * NTHR;
        const int L = ph / PH_PER_LAYER, k = ph - L * PH_PER_LAYER, jm = L >> 1;
        const bool attn = !(L & 1);
        if (ph == NPHASES - 1) {
            final_norm_phase(X, P.in[31 + z], gw, ngw, lane);
        } else if (k == 0) {
            LAS float* scr = (LAS float*)(lds + wave * 16384);
            const int njobs = attn ? 8 : 10; int total = 0;
            for (int jb = 0; jb < njobs; ++jb) total += get_job(P, z, ws, L, jb).nitems;
            for (int it = gw; it < total; it += ngw) {
                int r = it;
                for (int jb = 0; jb < njobs; ++jb) { const TJob j = get_job(P, z, ws, L, jb); if (r < j.nitems) { transpose_item(j.src, j.K, j.N, j.dst, j.mode, scr, r, lane); break; } r -= j.nitems; }
            }
            if (!attn) {
                unsigned char* mx = wb + W_MX;
                fill_l1((bf16_t*)(mx + MX_L1), P.in[15 + z] + (size_t)jm * 2 * 1024 * 64, 2, 64, gtid, gthreads);
                fill_l1((bf16_t*)(mx + MX_L1 + 512 * KiB), P.in[18 + z] + (size_t)jm * 2 * 1024 * 64, 2, 64, gtid, gthreads);
                fill_l1((bf16_t*)(mx + MX_L1 + 1024 * KiB), P.in[20 + z] + (size_t)jm * 1024 * 128, 1, 128, gtid, gthreads);
                if (jm > 0) fill_l1((bf16_t*)(mx + MX_L1 + 1536 * KiB), P.in[29 + z] + (size_t)(jm - 1) * 1024 * 32, 1, 32, gtid, gthreads);
                fill_l2bd((bf16_t*)(mx + MX_L2W), P.in[16 + z] + (size_t)jm * 2 * 64 * 1024, gtid, gthreads);
                fill_l2bd((bf16_t*)(mx + MX_L2A), P.in[19 + z] + (size_t)jm * 2 * 64 * 1024, gtid, gthreads);
                fill_l2((bf16_t*)(mx + MX_L2G), P.in[21 + z] + (size_t)jm * 128 * 1024, 128, gtid, gthreads);
                if (jm > 0) fill_l2((bf16_t*)(mx + MX_L2V), P.in[30 + z] + (size_t)(jm - 1) * 32 * 1024, 32, gtid, gthreads);
            }
            if (L == 0) { __syncthreads(); mods_phase(P, z, ws, lds, tid); }
        } else if (k == 1 || k == 10 || (k == 4 && attn)) {
            const int sub = (k == 1) ? 0 : (k == 4 ? 1 : 2);
            const float* xin = (L == 0 && k == 1) ? P.in[0 + z] : X;
            norm_phase(xin, H, P.in[4 + z] + (size_t)(L * 3 + sub) * DM, mod_vec(ws, L, 3 * sub), mod_vec(ws, L, 3 * sub + 1), gw, ngw, lane);
        } else if (k == 2 || k == 11) {
            const int f = (k == 11);
            pg8::Gemm g{H, (const bf16_t*)(wb + (f ? W_F1G : W_F0G)), TT, 2 * DFF, DM};
            pg8::GenOrder S; S.so.init(TT, 2 * DFF, gridDim.x, blockIdx.x); S.single = 0; S.pm = 0; S.pn = 0;
            pg8::EpiSwiglu E{(bf16_t*)(big + B_HID), DFF};

#ifndef SKIP_SWI
            pg8::gemm_phase<pg8::EpiSwiglu, pg8::GenOrder, true, true>(lds, g, S, E);
#endif

        } else if (k == 3 || k == 12 || k == 9) {
            pg8::Gemm g; pg8::EpiResid E;
            if (k == 9) {
                g = pg8::Gemm{attn ? H : (const bf16_t*)(big + B_POST), (const bf16_t*)(wb + W_MX + (attn ? MX_AWO : MX_RWO)), TT, DM, DM};
                E = pg8::EpiResid{X, X, mod_vec(ws, L, 5), 9216, 1.0f / MK_REP_GEMM};
            } else {
                const int f = (k == 12);
                g = pg8::Gemm{(const bf16_t*)(big + B_HID), (const bf16_t*)(wb + (f ? W_F1D : W_F0D)), TT, DM, DFF};
                E = pg8::EpiResid{(L == 0 && k == 3) ? P.in[0 + z] : X, X, mod_vec(ws, L, f ? 8 : 2), 9216, (L == 0 && k == 3) ? 0.5f : 0.5f / MK_REP_GEMM};
            }
            pg8::GenOrder S; S.so.init(TT, DM, gridDim.x, blockIdx.x); S.single = 0; S.pm = 0; S.pn = 0;

#ifndef SKIP_RES
            pg8::gemm_phase<pg8::EpiResid, pg8::GenOrder, true, true>(lds, g, S, E);
#endif

        } else if (k == 4) {
            mix_phase(X, (bf16_t*)(big + B_MIX), P.in[4 + z] + (size_t)(L * 3 + 1) * DM, mod_vec(ws, L, 3), mod_vec(ws, L, 4), P.in[12 + z] + (size_t)jm * 6 * DM, gw, ngw, lane);
        } else if (k == 5 || (k == 6 && !attn)) {
            const int nsub = attn ? 1 : (k == 5 ? 4 : 3);
            bf16_t* vdst = (jm == 0) ? (bf16_t*)(ws + WS_VF) : (bf16_t*)(big + B_V);
            for (int s = 0; s < nsub; ++s) {
                pg8::Gemm g; pg8::EpiBf16Out E; pg8::GenOrder S; S.single = 0; S.pm = 0; S.pn = 0; int N = DM;
                if (attn) { g = pg8::Gemm{H, (const bf16_t*)(wb + W_MX + MX_QKV), TT, NQKV, DM}; E = pg8::EpiBf16Out{(bf16_t*)(big + B_QKV), NQKV, nullptr, 0, NQKV}; N = NQKV; }
                else if (k == 5 && s < 3) {
                    const int mixi = (s == 0) ? 0 : (s == 1 ? 2 : 3);
                    bf16_t* dst = (s == 0) ? (bf16_t*)(big + B_R) : (s == 1 ? (bf16_t*)(big + B_K) : vdst);
                    g = pg8::Gemm{(const bf16_t*)(big + B_MIX) + (size_t)mixi * TT * DM, (const bf16_t*)(wb + W_MX + MX_WR + (size_t)s * 2 * MiB), TT, DM, DM};
                    E = pg8::EpiBf16Out{dst, DM, nullptr, 0, DM};
                } else if (k == 5) {
                    const int q = blockIdx.x >> 6; const int mixi = (q == 0) ? 1 : (q == 1 ? 4 : (q == 2 ? 5 : 3));
                    g = pg8::Gemm{(const bf16_t*)(big + B_MIX) + (size_t)mixi * TT * DM, (const bf16_t*)(wb + W_MX + MX_L1 + (size_t)q * 512 * KiB), TT, 256, DM};
                    E = pg8::EpiBf16Out{(bf16_t*)(big + B_L1 + (size_t)q * 4 * MiB), 128, nullptr, (q == 0) ? 1 : (q == 2 ? 2 : 0), 128};
                    S.single = 1; S.pm = (blockIdx.x < 256 && !(q == 3 && jm == 0)) ? (int)(blockIdx.x & 63) : -1; S.pn = 0; N = 256;
                } else if (s == 0) {
                    g = pg8::Gemm{(const bf16_t*)(big + B_L1 + 4 * MiB), (const bf16_t*)(wb + W_MX + MX_L2A), TT, 2048, 128}; N = 2048;
                    E = pg8::EpiBf16Out{(bf16_t*)(big + B_A), 2048, P.in[17 + z] + (size_t)jm * 2 * DM, 2, 2048};
                } else if (s == 1) {
                    g = pg8::Gemm{(const bf16_t*)(big + B_L1 + 8 * MiB), (const bf16_t*)(wb + W_MX + MX_L2G), TT, DM, 128};
                    E = pg8::EpiBf16Out{(bf16_t*)(big + B_G), DM, nullptr, 0, DM};
                } else {
                    g = pg8::Gemm{(const bf16_t*)(big + B_L1 + 12 * MiB), (const bf16_t*)(wb + W_MX + MX_L2V), TT, DM, 128};
                    E = pg8::EpiBf16Out{H, DM, P.in[28 + z], 2, DM};
                    if (jm == 0) { S.single = 1; S.pm = -1; }
                }
                if (!S.single) S.so.init(TT, N, gridDim.x, blockIdx.x);

#ifndef SKIP_BF
                pg8::gemm_phase<pg8::EpiBf16Out, pg8::GenOrder, true, true>(lds, g, S, E);
#endif

            }
            if (!attn && k == 6) {
                pg8::Gemm g{(const bf16_t*)(big + B_L1), (const bf16_t*)(wb + W_MX + MX_L2W), TT, 2048, 128};
                pg8::EpiF32Out E{(float*)(big + B_DEC), 2048, P.in[14 + z] + (size_t)jm * 2 * DM, 3};
                pg8::GenOrder S; S.so.init(TT, 2048, gridDim.x, blockIdx.x); S.single = 0; S.pm = 0; S.pn = 0;

#ifndef SKIP_F32
                pg8::gemm_phase<pg8::EpiF32Out, pg8::GenOrder, true, true>(lds, g, S, E);
#endif

            }
        } else if (k == 6) {
            qkrope_phase((bf16_t*)(big + B_QKV), P.in[9 + z] + (size_t)jm * 128, P.in[10 + z] + (size_t)jm * 128, gw, ngw, lane);
        } else if (k == 7 && attn) {
            const att::bf16* qkv = (const att::bf16*)(big + B_QKV);
            for (int uu = blockIdx.x; uu < 512 * MK_REP_ATT; uu += gridDim.x) {
                const int u = uu & 511, b = u >> 8, hq = (u >> 5) & 7, qb = u & 31; const size_t r0 = (size_t)b * SEQ;

#ifndef SKIP_ATT
                att::attn_dense_body<att::bf16>(qkv + (r0 + qb * 256) * NQKV + hq * 128, qkv + r0 * NQKV + 1024 + (hq >> 2) * 128, qkv + r0 * NQKV + 1280 + (hq >> 2) * 128,
                                                (att::bf16*)H + (r0 + qb * 256) * DM + hq * 128, SEQ, (char*)lds_raw);
#endif

                __syncthreads();
            }
        } else if (k == 7) {
            ScanIn I; I.R = (const bf16_t*)(big + B_R); I.K = (const bf16_t*)(big + B_K); I.V = (jm == 0) ? (const bf16_t*)(ws + WS_VF) : (const bf16_t*)(big + B_V);
            I.A = (const bf16_t*)(big + B_A); I.VF = (const bf16_t*)(ws + WS_VF); I.VG = H; I.DEC = (const float*)(big + B_DEC);
            I.Y0 = (float*)(big + B_Y0); I.Y1 = (float*)(big + B_Y1); I.k_k = P.in[22 + z] + (size_t)jm * DM; I.k_a = P.in[23 + z] + (size_t)jm * DM; I.has_vres = jm > 0;

#ifndef SKIP_SCAN
            for (int u = blockIdx.x; u < 256 * MK_REP_SCAN; u += gridDim.x) scan_unit(I, lds, u & 255, tid);
#endif

        } else if (k == 8 && !attn) {
            PostIn I; I.Y0 = (const float*)(big + B_Y0); I.Y1 = (const float*)(big + B_Y1); I.R = (const bf16_t*)(big + B_R); I.K = (const bf16_t*)(big + B_K);
            I.V = (jm == 0) ? (const bf16_t*)(ws + WS_VF) : (const bf16_t*)(big + B_V); I.A = (const bf16_t*)(big + B_A); I.G = (const bf16_t*)(big + B_G);
            I.VF = (const bf16_t*)(ws + WS_VF); I.VG = H; I.k_a = P.in[23 + z] + (size_t)jm * DM; I.r_k = P.in[24 + z] + (size_t)jm * DM; I.ln_w = P.in[25 + z] + (size_t)jm * DM; I.ln_b = P.in[26 + z] + (size_t)jm * DM;
            I.O = (bf16_t*)(big + B_POST); I.has_vres = jm > 0;
            post_phase(I, gw, ngw, lane);
        }
        if (ph + 1 < P.ph_hi) { for (int rr = 0; rr < MK_REP_SYNC; ++rr) { if (ph == P.ph_lo) grid.sync(); else xcd_barrier(bar); } }
    }
}

extern "C" void kernel_launch(void* const* d_in, const int* in_sizes, int n_in, void* d_out, int out_size, void* d_ws, size_t ws_size, hipStream_t stream) {
    static int grid_blocks = 0;
    if (grid_blocks == 0) {
        if (n_in != 32 || out_size != TT * DM || ws_size < WS_END) { fprintf(stderr, "kernel_launch: unexpected shapes: n_in %d out %d ws %zu (need %zu)\n", n_in, out_size, ws_size, (size_t)WS_END); grid_blocks = -1; return; }
        int dev = 0, cus = 0, per_cu = 0;
        hipGetDevice(&dev);
        hipDeviceGetAttribute(&cus, hipDeviceAttributeMultiprocessorCount, dev);
        if (hipFuncSetAttribute((const void*)fwd_megakernel, hipFuncAttributeMaxDynamicSharedMemorySize, LDS_BYTES) != hipSuccess) { fprintf(stderr, "kernel_launch: hipFuncSetAttribute failed\n"); grid_blocks = -1; return; }
        if (hipOccupancyMaxActiveBlocksPerMultiprocessor(&per_cu, (const void*)fwd_megakernel, NTHR, LDS_BYTES) != hipSuccess || per_cu < 1) { fprintf(stderr, "kernel_launch: occupancy query gave %d\n", per_cu); per_cu = 1; }
        (void)hipGetLastError();
        grid_blocks = cus * 1;
        fprintf(stderr, "kernel_launch: cus %d per_cu %d grid %d\n", cus, per_cu, grid_blocks);
    }
    if (grid_blocks < 0) return;
    Params p{};
    for (int i = 0; i < 32; ++i) p.in[i] = (const float*)d_in[i];
    p.in[32] = (const float*)d_out; p.in[33] = (const float*)d_ws;
#ifdef MK_MULTI_LAUNCH
    for (int ph = 0; ph < NPHASES; ++ph) { p.ph_lo = ph; p.ph_hi = ph + 1; hipLaunchKernelGGL(fwd_megakernel, dim3(grid_blocks), dim3(NTHR), LDS_BYTES, stream, p); }
#else
    p.ph_lo = 0; p.ph_hi = NPHASES;
    if (hipMemsetAsync(d_ws, 0, 16384, stream) != hipSuccess) { fprintf(stderr, "kernel_launch: memset of the barrier words failed\n"); return; }
    void* args[] = {&p};
    hipError_t e = hipLaunchCooperativeKernel((const void*)fwd_megakernel, dim3(grid_blocks), dim3(NTHR), args, LDS_BYTES, stream);
    if (e != hipSuccess) fprintf(stderr, "cooperative launch failed: %s (grid %d)\n", hipGetErrorString(e), grid_blocks);
#endif
}
```

```cpp
#include <hip/hip_runtime.h>
#include <hip/hip_cooperative_groups.h>
#include <hip/hip_bf16.h>
#include <cstdio>
#include <cstdint>
namespace cg = cooperative_groups;
__device__ __forceinline__ int mk_tid() { int t = threadIdx.x; asm volatile("" : "+v"(t)); return t; }
#define MK_REP_GEMM 1
namespace pg8 {
#define PG8_LAS __attribute__((address_space(3)))
typedef unsigned short bf16_t;
typedef short bf16x8 __attribute__((ext_vector_type(8)));
typedef float f32x4 __attribute__((ext_vector_type(4)));
typedef unsigned u32x4 __attribute__((ext_vector_type(4)));
constexpr int BM = 256, BK = 64, HALF = 128, HTB = HALF * BK * 2  , STAGE_BYTES = 8 * HTB, NXCD = 8, WGM = 8;

__host__ __device__ __forceinline__ int lds_byte(int r, int c) { const int st = (r >> 4) * 2 + (c >> 5), rr = r & 15, cc = c & 31, ob = rr * 64 + cc * 2; return st * 1024 + (ob ^ (((ob >> 9) & 1) << 5)); }
__host__ __device__ __forceinline__ void stage_rc(int b, int& R, int& C) { const int st = b / 1024, sb = b % 1024, swz = sb ^ (((sb >> 9) & 1) << 5); R = (st >> 1) * 16 + swz / 64; C = (st & 1) * 32 + (swz % 64) / 2; }
__host__ __device__ __forceinline__ int perm32(int rho) { const int n = rho >> 4, i = rho & 15; return 8 * (i >> 2) + 4 * n + (i & 3); }

struct Unit { int pm, pn; };
struct Gemm { const bf16_t* A; const bf16_t* Bt; int M, N, K; };

struct StaticOrder {
    int nM, nN, nwg, G, c;
    __host__ __device__ void init(int M, int N, int G_, int c_) { nM = M / BM; nN = N / BM; nwg = nM * nN; G = G_; c = c_; }
    __host__ __device__ bool next(int i, Unit& u) const {
        const long L = (long)i * G + c; if (L >= nwg) return false;
        int wgid = (int)L; { const int q = nwg / NXCD, r = nwg % NXCD, xcd = wgid % NXCD, off = wgid / NXCD; wgid = (xcd < r ? xcd * (q + 1) : r * (q + 1) + (xcd - r) * q) + off; }
        const int nig = WGM * nN, gid = wgid / nig, fm = gid * WGM, gsz = (nM - fm) < WGM ? (nM - fm) : WGM;
        u.pm = fm + ((wgid % nig) % gsz); u.pn = (wgid % nig) / gsz; return true;
    }
    __device__ __forceinline__ void a_ready(const Unit&) const {}
    __device__ __forceinline__ void done(const Unit&) const {}
};

__device__ __forceinline__ unsigned cvt_pk_bf16(float lo, float hi) { unsigned r; asm volatile("v_cvt_pk_bf16_f32 %0, %1, %2" : "=v"(r) : "v"(lo), "v"(hi)); return r; }
typedef float f32x2 __attribute__((ext_vector_type(2)));
typedef unsigned u32x2 __attribute__((ext_vector_type(2)));

struct GenOrder {
    StaticOrder so; int single, pm, pn;
    __device__ bool next(int i, Unit& u) const {
        if (single) { if (i >= MK_REP_GEMM || pm < 0) return false; u.pm = pm; u.pn = pn; return true; }
        if (MK_REP_GEMM > 1) { const int rounds = (so.nwg - so.c + so.G - 1) / so.G; if (i >= rounds) i -= rounds; }
        return so.next(i, u); }
    __device__ __forceinline__ void a_ready(const Unit&) const {}
    __device__ __forceinline__ void done(const Unit&) const {}
};

__device__ __forceinline__ float fsigmoid(float z) { return __builtin_amdgcn_rcpf(1.0f + __builtin_amdgcn_exp2f(-1.4426950408889634f * z)); }
__device__ __forceinline__ float act_apply(float z, int act) {
    if (act == 1) return 1.0f - 2.0f * __builtin_amdgcn_rcpf(1.0f + __builtin_amdgcn_exp2f(2.8853900817779268f * z));
    if (act == 2) return fsigmoid(z);
    if (act == 3) return __builtin_amdgcn_exp2f(-0.8750387749145276f * fsigmoid(z));
    return z;
}

struct EpiBf16Out {
    static constexpr bool PERM = true, AFTER_DRAIN = false;
    bf16_t* O; int ldc; const float* bias; int act; int nvalid;
    __device__ __forceinline__ void operator()(const f32x4 (&acc)[2][2][4][2], const Unit& u, int, int, int, int) const {
        const int t2 = mk_tid(), wr = t2 >> 8, wc = (t2 >> 6) & 3, fr = t2 & 15, fq = (t2 >> 4) & 3;
        const int row0 = u.pm * BM + wr * 64 + fr;
#pragma unroll
        for (int bj = 0; bj < 2; ++bj) {
            const int colb = u.pn * BM + bj * HALF + wc * 32 + 8 * fq;
            if (colb >= nvalid) continue;
            f32x4 b0 = (f32x4){0.f, 0.f, 0.f, 0.f}, b1 = b0;
            if (bias) { b0 = *(const f32x4*)(bias + colb); b1 = *(const f32x4*)(bias + colb + 4); }
#pragma unroll
            for (int ai = 0; ai < 2; ++ai)
#pragma unroll
                for (int m = 0; m < 4; ++m) {
                    f32x4 v0 = acc[ai][bj][m][0] + b0, v1 = acc[ai][bj][m][1] + b1;
                    if (act != 0) {
#pragma unroll
                        for (int e = 0; e < 4; ++e) { v0[e] = act_apply(v0[e], act); v1[e] = act_apply(v1[e], act); }
                    }
                    u32x4 w; w.x = cvt_pk_bf16(v0[0], v0[1]); w.y = cvt_pk_bf16(v0[2], v0[3]); w.z = cvt_pk_bf16(v1[0], v1[1]); w.w = cvt_pk_bf16(v1[2], v1[3]);
                    *(u32x4*)(O + (size_t)(row0 + ai * HALF + m * 16) * ldc + colb) = w;
                }
        }
    }
};
struct EpiF32Out {
    static constexpr bool PERM = false, AFTER_DRAIN = false;
    float* O; int ldc; const float* bias; int act;
    __device__ __forceinline__ void operator()(const f32x4 (&acc)[2][2][4][2], const Unit& u, int, int, int, int) const {
        const int t2 = mk_tid(), wr = t2 >> 8, wc = (t2 >> 6) & 3, fr = t2 & 15, fq = (t2 >> 4) & 3;
        const int row0 = u.pm * BM + wr * 64 + fr;
#pragma unroll
        for (int bj = 0; bj < 2; ++bj)
#pragma unroll
            for (int n = 0; n < 2; ++n) {
                const int col = u.pn * BM + bj * HALF + wc * 32 + 16 * n + 4 * fq;
                f32x4 b0 = (f32x4){0.f, 0.f, 0.f, 0.f};
                if (bias) b0 = *(const f32x4*)(bias + col);
#pragma unroll
                for (int ai = 0; ai < 2; ++ai)
#pragma unroll
                    for (int m = 0; m < 4; ++m) {
                        f32x4 v = acc[ai][bj][m][n] + b0;
#pragma unroll
                        for (int e = 0; e < 4; ++e) v[e] = __builtin_amdgcn_exp2f(-0.8750387749145276f * fsigmoid(v[e]));
                        *(f32x4*)(O + (size_t)(row0 + ai * HALF + m * 16) * ldc + col) = v;
                        if (m & 1) asm volatile("" ::: "memory");
                    }
            }
    }
};
struct EpiResid {
    static constexpr bool PERM = false, AFTER_DRAIN = false;
    const float* base; float* out; const float* gate; int gstride; float coef;
    __device__ __forceinline__ void operator()(const f32x4 (&acc)[2][2][4][2], const Unit& u, int, int, int, int) const {
        const int t2 = mk_tid(), wr = t2 >> 8, wc = (t2 >> 6) & 3, fr = t2 & 15, fq = (t2 >> 4) & 3;
        const int row0 = u.pm * BM + wr * 64 + fr;
        const float* gb = gate + (size_t)((u.pm * BM) >> 13) * gstride;
#pragma unroll
        for (int bj = 0; bj < 2; ++bj)
#pragma unroll
            for (int n = 0; n < 2; ++n) {
                const int col = u.pn * BM + bj * HALF + wc * 32 + 16 * n + 4 * fq;
                const f32x4 gv = *(const f32x4*)(gb + col) * coef;
#pragma unroll
                for (int ai = 0; ai < 2; ++ai)
#pragma unroll
                    for (int m = 0; m < 4; ++m) {
                        const size_t off = (size_t)(row0 + ai * HALF + m * 16) * 1024 + col;
                        const f32x4 bs = *(const f32x4*)(base + off);
                        *(f32x4*)(out + off) = bs + gv * acc[ai][bj][m][n];
                    }
            }
    }
};
struct EpiSwiglu {
    static constexpr bool PERM = true, AFTER_DRAIN = false;
    bf16_t* O; int ldc;
    __device__ __forceinline__ void operator()(const f32x4 (&acc)[2][2][4][2], const Unit& u, int, int, int, int) const {
        const int t2 = mk_tid(), wr = t2 >> 8, wc = (t2 >> 6) & 3, fr = t2 & 15, fq = (t2 >> 4) & 3;
        const int row0 = u.pm * BM + wr * 64 + fr;
        const int colb = u.pn * HALF + wc * 32 + 8 * fq;
#pragma unroll
        for (int ai = 0; ai < 2; ++ai)
#pragma unroll
            for (int m = 0; m < 4; ++m) {
                f32x4 g0 = acc[ai][0][m][0], g1 = acc[ai][0][m][1];
                const f32x4 u0 = acc[ai][1][m][0], u1 = acc[ai][1][m][1];
#pragma unroll
                for (int e = 0; e < 4; ++e) { g0[e] = g0[e] * fsigmoid(g0[e]) * u0[e]; g1[e] = g1[e] * fsigmoid(g1[e]) * u1[e]; }
                u32x4 w; w.x = cvt_pk_bf16(g0[0], g0[1]); w.y = cvt_pk_bf16(g0[2], g0[3]); w.z = cvt_pk_bf16(g1[0], g1[1]); w.w = cvt_pk_bf16(g1[2], g1[3]);
                *(u32x4*)(O + (size_t)(row0 + ai * HALF + m * 16) * ldc + colb) = w;
            }
    }
};

template <class Epi, class Sched, bool ALIGN_EPI = false, bool SP2 = false>
__device__ __forceinline__ void gemm_phase(PG8_LAS unsigned char* lds, const Gemm g, const Sched& S, const Epi& E) {
    const int tid = mk_tid(), wid = __builtin_amdgcn_readfirstlane(tid >> 6), lane = tid & 63, wr = wid >> 2, wc = wid & 3, fr = lane & 15, fq = lane >> 4;
    const int K = g.K, nt = K / BK;
    unsigned voffA[2], voffB[2];
#pragma unroll
    for (int i = 0; i < 2; ++i) { int R, C; stage_rc(tid * 16 + i * 8192, R, C); const int Rb = Epi::PERM ? ((R & ~31) + perm32(R & 31)) : R;
        voffA[i] = (unsigned)(R * K + C) * 2u; voffB[i] = (unsigned)(Rb * K + C) * 2u; }
    const size_t kstep = (size_t)(BK * 2);
    const size_t hstep = (size_t)HALF * K * 2;
    const size_t tstep = 2 * hstep;
    const unsigned ldsw = (unsigned)wid * 1024u;
    const int aoff = lds_byte(wr * 64 + fr, fq * 8), boff = lds_byte(wc * 32 + fr, fq * 8);
#define PG8_SA(b, h) (((b) * 2 + (h)) * HTB)
#define PG8_SB(b, h) ((4 + (b) * 2 + (h)) * HTB)
#define PG8_STAGE(bufoff, gbase, voff) do { _Pragma("unroll") for (int _i = 0; _i < 2; ++_i) \
        __builtin_amdgcn_global_load_lds((const unsigned*)((const char*)(gbase) + (voff)[_i]), (PG8_LAS unsigned*)(lds + (bufoff) + ldsw + _i * 8192), 16, 0, 0); } while (0)
#define PG8_LDA(dst, b, h) do { _Pragma("unroll") for (int m = 0; m < 4; ++m) _Pragma("unroll") for (int k = 0; k < 2; ++k) dst[m][k] = *(const PG8_LAS bf16x8*)(lds + PG8_SA(b, h) + aoff + m * 2048 + k * 1024); } while (0)
#define PG8_LDB(dst, b, h) do { _Pragma("unroll") for (int n = 0; n < 2; ++n) _Pragma("unroll") for (int k = 0; k < 2; ++k) dst[n][k] = *(const PG8_LAS bf16x8*)(lds + PG8_SB(b, h) + boff + n * 2048 + k * 1024); } while (0)
#define PG8_MMA(ai, bj, At, Bt) do { __builtin_amdgcn_s_setprio(1); _Pragma("unroll") for (int m = 0; m < 4; ++m) _Pragma("unroll") for (int n = 0; n < 2; ++n) _Pragma("unroll") for (int k = 0; k < 2; ++k) \
        acc[ai][bj][m][n] = __builtin_amdgcn_mfma_f32_16x16x32_bf16(Bt[n][k], At[m][k], acc[ai][bj][m][n], 0, 0, 0); __builtin_amdgcn_s_setprio(0); } while (0)
#define PG8_WAIT_V(n) asm volatile("s_waitcnt vmcnt(" #n ")" ::: "memory")
#define PG8_WAIT_L(n) asm volatile("s_waitcnt lgkmcnt(" #n ")" ::: "memory")
#define PG8_BAR __builtin_amdgcn_s_barrier()
#define PG8_SCHED __builtin_amdgcn_sched_barrier(0)
    Unit cur, nxt; int ui = 0;
    if (!S.next(0, cur)) return;
    f32x4 acc[2][2][4][2];
#pragma unroll
    for (int a = 0; a < 2; ++a)
#pragma unroll
        for (int b = 0; b < 2; ++b)
#pragma unroll
            for (int m = 0; m < 4; ++m)
#pragma unroll
                for (int n = 0; n < 2; ++n) acc[a][b][m][n] = (f32x4){0.f, 0.f, 0.f, 0.f};
    bf16x8 At[4][2], B0[2][2], B1[2][2];
    const char* cA = (const char*)g.A + (size_t)cur.pm * tstep; const char* cB = (const char*)g.Bt + (size_t)cur.pn * tstep;
    S.a_ready(cur);
    if constexpr (SP2) {
        PG8_STAGE(PG8_SB(0, 0), cB, voffB); PG8_STAGE(PG8_SB(0, 1), cB + hstep, voffB); PG8_STAGE(PG8_SA(0, 0), cA, voffA); PG8_STAGE(PG8_SA(0, 1), cA + hstep, voffA);
        if (wr == 1) PG8_BAR;
        PG8_WAIT_V(2); PG8_BAR;
        PG8_STAGE(PG8_SB(1, 0), cB + kstep, voffB); PG8_STAGE(PG8_SA(1, 0), cA + kstep, voffA); PG8_STAGE(PG8_SB(1, 1), cB + hstep + kstep, voffB);
        PG8_WAIT_V(6); PG8_BAR;
    } else {
        PG8_STAGE(PG8_SB(0, 0), cB, voffB); PG8_STAGE(PG8_SA(0, 0), cA, voffA); PG8_STAGE(PG8_SB(0, 1), cB + hstep, voffB); PG8_STAGE(PG8_SA(0, 1), cA + hstep, voffA);
        if (wr == 1) PG8_BAR;
        PG8_WAIT_V(4); PG8_BAR;
        PG8_STAGE(PG8_SB(1, 0), cB + kstep, voffB); PG8_STAGE(PG8_SA(1, 0), cA + kstep, voffA); PG8_STAGE(PG8_SB(1, 1), cB + hstep + kstep, voffB);
        PG8_WAIT_V(6); PG8_BAR;
    }
    for (;;) {
        const bool has_next = S.next(ui + 1, nxt);
        const char* nA = has_next ? (const char*)g.A + (size_t)nxt.pm * tstep : cA; const char* nB = has_next ? (const char*)g.Bt + (size_t)nxt.pn * tstep : cB;
        for (int t = 0; t < nt; t += 2) {
            const bool last = (t == nt - 2);
            const char* a1 = cA + (size_t)(t + 1) * kstep;
            const char* a2 = last ? nA : cA + (size_t)(t + 2) * kstep; const char* b2 = last ? nB : cB + (size_t)(t + 2) * kstep;
            const char* a3 = a2 + kstep; const char* b3 = b2 + kstep;
            if (last && has_next) S.a_ready(nxt);
            if constexpr (SP2) {
            PG8_LDB(B0, 0, 0); PG8_LDB(B1, 0, 1); PG8_SCHED; PG8_LDA(At, 0, 0); PG8_STAGE(PG8_SA(1, 1), a1 + hstep, voffA);
            PG8_WAIT_V(8); PG8_WAIT_L(0); PG8_BAR; PG8_MMA(0, 0, At, B0); PG8_MMA(0, 1, At, B1); PG8_BAR; PG8_SCHED;
            PG8_LDA(At, 0, 1); PG8_STAGE(PG8_SB(0, 0), b2, voffB); PG8_STAGE(PG8_SB(0, 1), b2 + hstep, voffB); PG8_STAGE(PG8_SA(0, 0), a2, voffA);
            PG8_WAIT_V(8); PG8_WAIT_L(0); PG8_BAR; PG8_MMA(1, 0, At, B0); PG8_MMA(1, 1, At, B1); PG8_BAR; PG8_SCHED;
            PG8_LDB(B0, 1, 0); PG8_LDB(B1, 1, 1); PG8_SCHED; PG8_LDA(At, 1, 0); PG8_STAGE(PG8_SA(0, 1), a2 + hstep, voffA);
            PG8_WAIT_V(8); PG8_WAIT_L(0); PG8_BAR; PG8_MMA(0, 0, At, B0); PG8_MMA(0, 1, At, B1); PG8_BAR; PG8_SCHED;
            PG8_LDA(At, 1, 1); PG8_STAGE(PG8_SB(1, 0), b3, voffB); PG8_STAGE(PG8_SB(1, 1), b3 + hstep, voffB); PG8_STAGE(PG8_SA(1, 0), a3, voffA);
            PG8_WAIT_V(8); PG8_WAIT_L(0); PG8_BAR; PG8_MMA(1, 0, At, B0); PG8_MMA(1, 1, At, B1); PG8_BAR; PG8_SCHED;
            } else {
            PG8_LDB(B0, 0, 0); PG8_SCHED; PG8_LDA(At, 0, 0); PG8_STAGE(PG8_SA(1, 1), a1 + hstep, voffA);
            PG8_WAIT_L(8); PG8_BAR; PG8_WAIT_L(0); PG8_MMA(0, 0, At, B0); PG8_BAR; PG8_SCHED;
            PG8_LDB(B1, 0, 1); PG8_STAGE(PG8_SB(0, 0), b2, voffB);
            PG8_BAR; PG8_WAIT_L(0); PG8_MMA(0, 1, At, B1); PG8_BAR;
            PG8_LDA(At, 0, 1); PG8_STAGE(PG8_SA(0, 0), a2, voffA);
            PG8_BAR; PG8_WAIT_L(0); PG8_MMA(1, 0, At, B0); PG8_BAR; PG8_SCHED;
            PG8_STAGE(PG8_SB(0, 1), b2 + hstep, voffB);
            PG8_WAIT_V(6); PG8_BAR; PG8_MMA(1, 1, At, B1); PG8_BAR;
            PG8_LDB(B0, 1, 0); PG8_SCHED; PG8_LDA(At, 1, 0); PG8_STAGE(PG8_SA(0, 1), a2 + hstep, voffA);
            PG8_WAIT_L(8); PG8_BAR; PG8_WAIT_L(0); PG8_MMA(0, 0, At, B0); PG8_BAR; PG8_SCHED;
            PG8_LDB(B1, 1, 1); PG8_STAGE(PG8_SB(1, 0), b3, voffB);
            PG8_BAR; PG8_WAIT_L(0); PG8_MMA(0, 1, At, B1); PG8_BAR;
            PG8_LDA(At, 1, 1); PG8_STAGE(PG8_SA(1, 0), a3, voffA);
            PG8_BAR; PG8_WAIT_L(0); PG8_MMA(1, 0, At, B0); PG8_BAR; PG8_SCHED;
            PG8_STAGE(PG8_SB(1, 1), b3 + hstep, voffB);
            PG8_WAIT_V(6); PG8_BAR; PG8_MMA(1, 1, At, B1); PG8_BAR;
            }
        }
        if constexpr (ALIGN_EPI) { if (wr == 0) PG8_BAR; }
        if constexpr (!Epi::AFTER_DRAIN) { E(acc, cur, wr, wc, fr, fq); S.done(cur); }
        if (!has_next) break;
#pragma unroll
        for (int a = 0; a < 2; ++a)
#pragma unroll
            for (int b = 0; b < 2; ++b)
#pragma unroll
                for (int m = 0; m < 4; ++m)
#pragma unroll
                    for (int n = 0; n < 2; ++n) acc[a][b][m][n] = (f32x4){0.f, 0.f, 0.f, 0.f};
        cur = nxt; cA = nA; cB = nB; ++ui;
        if constexpr (ALIGN_EPI) { if (wr == 1) PG8_BAR; }
    }
    PG8_WAIT_V(0);
    if constexpr (!ALIGN_EPI) { if (wr == 0) PG8_BAR; }
    PG8_BAR;
    if constexpr (Epi::AFTER_DRAIN) { E.fused(acc, cur, wr, wc, fr, fq, lds, wid, lane); S.done(cur); }
#undef PG8_SA
#undef PG8_SB
#undef PG8_STAGE
#undef PG8_LDA
#undef PG8_LDB
#undef PG8_MMA
#undef PG8_WAIT_V
#undef PG8_WAIT_L
#undef PG8_BAR
#undef PG8_SCHED
}
}

namespace att {
using bf16 = __hip_bfloat16;
constexpr int   D = 128, NW = 8, QBLK = 32, KVBLK = 64;
constexpr float SCALE = 0.088388347648318440f;
constexpr float THR = 8.f;
constexpr int SDEPTH = 1;
constexpr int LDQ = 1536, LDK = 1536, LDO = 1024;
constexpr size_t SHM_V = KVBLK * D * 2, SHM_K = KVBLK * D * 2, SHM_ATTN = 2 * SHM_V + 2 * SHM_K + NW * 64 * 4;
using bf16x8 = __attribute__((ext_vector_type(8))) short;
using s16x4  = __attribute__((ext_vector_type(4))) short;
using f32x16 = __attribute__((ext_vector_type(16))) float;
using f32x8  = __attribute__((ext_vector_type(8))) float;
using u32x4  = __attribute__((ext_vector_type(4))) unsigned;
#define KSWZ(row, colB) ((row) * 256 + ((colB) ^ (((row) & 7) << 4)))
#define SBAR() __builtin_amdgcn_sched_barrier(0)
__device__ __forceinline__ int crow(int r, int hi) { return (r & 3) + 8 * (r >> 2) + 4 * hi; }
__device__ __forceinline__ unsigned cvtpk(float lo, float hi) {
  unsigned r; asm volatile("v_cvt_pk_bf16_f32 %0, %1, %2" : "=v"(r) : "v"(lo), "v"(hi)); return r;
}
template <typename TIn> struct Stage;
template <> struct Stage<bf16>  { using T = bf16x8;
  __device__ static __forceinline__ T ld8(const bf16* p) { return *reinterpret_cast<const bf16x8*>(p); }
  __device__ static __forceinline__ bf16x8 tobf(T x) { return x; } };
template <> struct Stage<float> { using T = f32x8;
  __device__ static __forceinline__ T ld8(const float* p) { return *reinterpret_cast<const f32x8*>(p); }
  __device__ static __forceinline__ bf16x8 tobf(T x) {
    u32x4 w = {cvtpk(x[0], x[1]), cvtpk(x[2], x[3]), cvtpk(x[4], x[5]), cvtpk(x[6], x[7])}; return *reinterpret_cast<bf16x8*>(&w); } };

__device__ __forceinline__ void partialSM(f32x16& p0, f32x16& p1, float& m_reg, float& mn, float& alpha) {
  constexpr float C = SCALE * 1.4426950408889634f;
  float pmax = p0[0]; for (int r = 1; r < 16; ++r) pmax = fmaxf(pmax, p0[r]); for (int r = 0; r < 16; ++r) pmax = fmaxf(pmax, p1[r]);
  { auto rr = __builtin_amdgcn_permlane32_swap(__float_as_uint(pmax), __float_as_uint(pmax), false, false);
    pmax = fmaxf(__uint_as_float(rr[0]), __uint_as_float(rr[1])); }
  if (__builtin_expect(__all(pmax - m_reg <= THR / SCALE), 1)) { mn = m_reg; alpha = 1.f; }
  else { mn = fmaxf(m_reg, pmax); alpha = __builtin_amdgcn_exp2f((m_reg - mn) * C); m_reg = mn; }
  float mnC = -mn * C;
  for (int r = 0; r < 16; ++r) p0[r] = fmaf(p0[r], C, mnC); for (int r = 0; r < 16; ++r) p1[r] = fmaf(p1[r], C, mnC);
  for (int r = 0; r < 16; ++r) p0[r] = __builtin_amdgcn_exp2f(p0[r]);
}
__device__ __forceinline__ void finishSM(f32x16& p0, f32x16& p1, float alpha, float& l_reg, bf16x8& pa0, bf16x8& pa1, bf16x8& pa2, bf16x8& pa3) {
  for (int r = 0; r < 16; ++r) p1[r] = __builtin_amdgcn_exp2f(p1[r]);
  float ps = 0; for (int r = 0; r < 16; ++r) ps += p0[r]; for (int r = 0; r < 16; ++r) ps += p1[r];
  { auto rr = __builtin_amdgcn_permlane32_swap(__float_as_uint(ps), __float_as_uint(ps), false, false);
    ps = __uint_as_float(rr[0]) + __uint_as_float(rr[1]); }
  l_reg = l_reg * alpha + ps;
#define PK4(P, BASE, OUT) do { unsigned a0 = cvtpk(P[BASE + 0], P[BASE + 1]), a1 = cvtpk(P[BASE + 2], P[BASE + 3]);   \
    unsigned b0 = cvtpk(P[BASE + 4], P[BASE + 5]), b1 = cvtpk(P[BASE + 6], P[BASE + 7]);                              \
    auto r0 = __builtin_amdgcn_permlane32_swap(a0, b0, false, false); auto r1 = __builtin_amdgcn_permlane32_swap(a1, b1, false, false); \
    u32x4 w = {r0[0], r1[0], r0[1], r1[1]}; OUT = *reinterpret_cast<bf16x8*>(&w); } while (0)
  PK4(p0, 0, pa0); PK4(p0, 8, pa1); PK4(p1, 0, pa2); PK4(p1, 8, pa3);
#undef PK4
}
__device__ __forceinline__ void qkt(f32x16& p0, f32x16& p1, const bf16* Ks, const bf16x8* qr, int r32, int hi) {
  p0 = f32x16{}; p1 = f32x16{};
  for (int d0 = 0; d0 < 8; ++d0) { int cb = (d0 * 16 + hi * 8) * 2;
    bf16x8 b0 = *reinterpret_cast<const bf16x8*>((const char*)Ks + KSWZ(r32, cb));
    bf16x8 b1 = *reinterpret_cast<const bf16x8*>((const char*)Ks + KSWZ(32 + r32, cb));
    p0 = __builtin_amdgcn_mfma_f32_32x32x16_bf16(b0, qr[d0], p0, 0, 0, 0);
    p1 = __builtin_amdgcn_mfma_f32_32x32x16_bf16(b1, qr[d0], p1, 0, 0, 0); }
}
__device__ __forceinline__ int v_st(int k, int c) { const int kk = (k & ~0xC) | ((k & 4) << 1) | ((k & 8) >> 1); return ((kk >> 3) * 4 + (c >> 5)) * 512 + ((kk & 7) * 32 + (c & 31)) * 2; }
__device__ __forceinline__ int v_rd_base(int lane) { return ((lane & 3) << 3) | (((lane >> 2) & 3) << 6) | (((lane >> 4) & 1) << 5) | (((lane >> 5) & 1) << 8); }
constexpr int v_rd_off(int d0, int ks, int half) { return d0 * 512 + ks * 4096 + half * 2048; }
template <int OFF> __device__ __forceinline__ s16x4 tr_read(int vb) {
  s16x4 r; asm volatile("ds_read_b64_tr_b16 %0, %1 offset:%2" : "=&v"(r) : "v"(vb), "i"(OFF) : "memory"); return r;
}
template <int D0> __device__ __forceinline__ void pv_one(f32x16& od, int vb, bf16x8 pa0, bf16x8 pa1, bf16x8 pa2, bf16x8 pa3) {
  const s16x4 l0 = tr_read<v_rd_off(D0, 0, 0)>(vb), h0 = tr_read<v_rd_off(D0, 0, 1)>(vb), l1 = tr_read<v_rd_off(D0, 1, 0)>(vb), h1 = tr_read<v_rd_off(D0, 1, 1)>(vb);
  const s16x4 l2 = tr_read<v_rd_off(D0, 2, 0)>(vb), h2 = tr_read<v_rd_off(D0, 2, 1)>(vb), l3 = tr_read<v_rd_off(D0, 3, 0)>(vb), h3 = tr_read<v_rd_off(D0, 3, 1)>(vb);
  asm volatile("s_waitcnt lgkmcnt(0)" ::: "memory"); SBAR();
#define PK(L, H) (bf16x8){L[0], L[1], L[2], L[3], H[0], H[1], H[2], H[3]}
  od = __builtin_amdgcn_mfma_f32_32x32x16_bf16(pa0, PK(l0, h0), od, 0, 0, 0);
  od = __builtin_amdgcn_mfma_f32_32x32x16_bf16(pa1, PK(l1, h1), od, 0, 0, 0);
  od = __builtin_amdgcn_mfma_f32_32x32x16_bf16(pa2, PK(l2, h2), od, 0, 0, 0);
  od = __builtin_amdgcn_mfma_f32_32x32x16_bf16(pa3, PK(l3, h3), od, 0, 0, 0);
#undef PK
}
__device__ __forceinline__ void pv_d0(f32x16* o, int vb, bf16x8 pa0, bf16x8 pa1, bf16x8 pa2, bf16x8 pa3) {
  pv_one<0>(o[0], vb, pa0, pa1, pa2, pa3); pv_one<1>(o[1], vb, pa0, pa1, pa2, pa3); pv_one<2>(o[2], vb, pa0, pa1, pa2, pa3); pv_one<3>(o[3], vb, pa0, pa1, pa2, pa3);
}

template <typename TQ>
__device__ __forceinline__ void attn_dense_body(const TQ* __restrict__ Qb, const bf16* __restrict__ Kh, const bf16* __restrict__ Vh,
                                                bf16* __restrict__ Ob, int seq, char* lds) {
  using St = Stage<bf16>; using SQ = Stage<TQ>;
  const int tid = mk_tid(), wid = tid >> 6, lane = tid & 63, r32 = lane & 31, hi = lane >> 5;
  bf16* V_lds = (bf16*)lds; bf16* K_lds = (bf16*)(lds + 2 * SHM_V);
  float* ws = (float*)(lds + 2 * SHM_V + 2 * SHM_K) + wid * 64; float* li_l = ws; float* al_l = ws + 32;
  float m_reg = -1e30f, l_reg = 0; f32x16 o[4] = {}; bf16x8 qr[8];
  const TQ* Qw = Qb + (long)(wid * QBLK + r32) * LDQ + hi * 8;
#pragma unroll
  for (int d0 = 0; d0 < 8; ++d0) qr[d0] = SQ::tobf(SQ::ld8(Qw + d0 * 16));
  const int sr = tid >> 4, sc = (tid & 15) * 8, vst0 = v_st(sr, sc), vst1 = v_st(32 + sr, sc);
  const int vb0 = (int)(uintptr_t)V_lds + v_rd_base(lane);
  struct { typename St::T vs0, vs1, ks0, ks1; } sr_[SDEPTH];
#define SLOAD(i, k0) do { sr_[i].vs0 = St::ld8(&Vh[(long)((k0) + sr) * LDK + sc]); sr_[i].vs1 = St::ld8(&Vh[(long)((k0) + 32 + sr) * LDK + sc]); \
    sr_[i].ks0 = St::ld8(&Kh[(long)((k0) + sr) * LDK + sc]); sr_[i].ks1 = St::ld8(&Kh[(long)((k0) + 32 + sr) * LDK + sc]); } while (0)
#define SWRITE(b, i) do { *(bf16x8*)((char*)V_lds + (b) * SHM_V + vst0) = St::tobf(sr_[i].vs0);          \
    *(bf16x8*)((char*)V_lds + (b) * SHM_V + vst1) = St::tobf(sr_[i].vs1); int kc = sc * 2;               \
    *(bf16x8*)((char*)K_lds + (b) * SHM_K + KSWZ(sr, kc)) = St::tobf(sr_[i].ks0);                       \
    *(bf16x8*)((char*)K_lds + (b) * SHM_K + KSWZ(32 + sr, kc)) = St::tobf(sr_[i].ks1); } while (0)
#define SWAIT() do { if constexpr (SDEPTH == 2) asm volatile("s_waitcnt vmcnt(4)" ::: "memory"); else asm volatile("s_waitcnt vmcnt(0)" ::: "memory"); } while (0)
#define RESC(a) do { if (__any((a) < 1.f)) { if (hi == 0) al_l[r32] = (a); asm volatile("s_waitcnt lgkmcnt(0)" ::: "memory"); \
    for (int d = 0; d < 4; ++d) for (int r = 0; r < 16; ++r) o[d][r] *= al_l[crow(r, hi)]; } } while (0)
  f32x16 pA0, pA1, pB0, pB1; float mnA, mnB, alA, alB; bf16x8 pa0, pa1, pa2, pa3; const int NT = seq / KVBLK;
  constexpr int SE = 0, SO = SDEPTH - 1;
  SLOAD(SE, 0); asm volatile("s_waitcnt vmcnt(0)" ::: "memory"); SWRITE(0, SE); __syncthreads();
  qkt(pA0, pA1, K_lds, qr, r32, hi); partialSM(pA0, pA1, m_reg, mnA, alA);
  SLOAD(SO, KVBLK); if constexpr (SDEPTH == 2) { if (2 < NT) SLOAD(SE, 2 * KVBLK); }
  SWAIT(); SWRITE(1, SO); __syncthreads();
  for (int j = 1; j + 1 < NT; j += 2) {
    SBAR(); qkt(pB0, pB1, (bf16*)((char*)K_lds + SHM_K), qr, r32, hi);
    finishSM(pA0, pA1, alA, l_reg, pa0, pa1, pa2, pa3); SBAR();
    SLOAD(SO, (j + SDEPTH) * KVBLK); SBAR();
    pv_d0(o, vb0, pa0, pa1, pa2, pa3); partialSM(pB0, pB1, m_reg, mnB, alB);
    __syncthreads(); SWAIT(); SWRITE(0, SE);
    RESC(alB); __syncthreads();
    SBAR(); qkt(pA0, pA1, K_lds, qr, r32, hi);
    finishSM(pB0, pB1, alB, l_reg, pa0, pa1, pa2, pa3); SBAR();
    if (SDEPTH == 1 || j + 3 < NT) SLOAD(SE, (j + 1 + SDEPTH) * KVBLK); SBAR();
    pv_d0(o, vb0 + (int)SHM_V, pa0, pa1, pa2, pa3); partialSM(pA0, pA1, m_reg, mnA, alA);
    __syncthreads(); SWAIT(); SWRITE(1, SO);
    RESC(alA); __syncthreads();
  }
  SBAR(); qkt(pB0, pB1, (bf16*)((char*)K_lds + SHM_K), qr, r32, hi);
  finishSM(pA0, pA1, alA, l_reg, pa0, pa1, pa2, pa3); SBAR();
  pv_d0(o, vb0, pa0, pa1, pa2, pa3); partialSM(pB0, pB1, m_reg, mnB, alB);
  __syncthreads(); RESC(alB);
  finishSM(pB0, pB1, alB, l_reg, pa0, pa1, pa2, pa3); SBAR();
  pv_d0(o, vb0 + (int)SHM_V, pa0, pa1, pa2, pa3);
  if (hi == 0) li_l[r32] = l_reg; asm volatile("s_waitcnt lgkmcnt(0)" ::: "memory");
  float rli[16];
#pragma unroll
  for (int r = 0; r < 16; ++r) rli[r] = __builtin_amdgcn_rcpf(li_l[crow(r, hi)]);
  unsigned short* Ow = (unsigned short*)Ob + (long)(wid * QBLK) * LDO;
#pragma unroll
  for (int r = 0; r < 16; ++r) { int orow = crow(r, hi);
    for (int d0 = 0; d0 < 4; ++d0) Ow[(long)orow * LDO + d0 * 32 + r32] = (unsigned short)(cvtpk(o[d0][r] * rli[r], 0.f) & 0xffffu); }
#undef SLOAD
#undef SWRITE
#undef SWAIT
#undef RESC
}
}

#define LAS __attribute__((address_space(3)))
typedef unsigned short bf16_t;
typedef float f32x4 __attribute__((ext_vector_type(4)));
typedef float f32x2 __attribute__((ext_vector_type(2)));
typedef unsigned u32x2 __attribute__((ext_vector_type(2)));
typedef unsigned u32x4 __attribute__((ext_vector_type(4)));

constexpr int BATCH = 2, SEQ = 8192, DM = 1024, TT = BATCH * SEQ, DFF = 2816, NQKV = 1536, DEPTH = 4;
constexpr int NTHR = 512, NWAVES = 8;
constexpr int LDS_BYTES = 147456;
constexpr size_t MiB = 1u << 20, KiB = 1024;
constexpr size_t WS_W = 1 * MiB, WS_MOD = 46 * MiB, WS_VF = 47 * MiB, WS_H = 79 * MiB, WS_BIG = 111 * MiB, WS_END = 575 * MiB;
constexpr size_t W_F0G = 0, W_F0D = 11 * MiB, W_F1G = 16 * MiB + 512 * KiB, W_F1D = 27 * MiB + 512 * KiB, W_MX = 33 * MiB;
constexpr size_t MX_QKV = 0, MX_AWO = 3 * MiB;
constexpr size_t MX_WR = 0, MX_RWO = 6 * MiB, MX_L1 = 8 * MiB  , MX_L2W = 10 * MiB, MX_L2A = 10 * MiB + 512 * KiB, MX_L2G = 11 * MiB, MX_L2V = 11 * MiB + 256 * KiB;
constexpr size_t B_HID = 0, B_QKV = 0;
constexpr size_t B_MIX = 0  , B_R = 192 * MiB, B_K = 224 * MiB, B_V = 256 * MiB, B_L1 = 288 * MiB  , B_G = 304 * MiB, B_A = 336 * MiB, B_Y1 = 400 * MiB;
constexpr size_t B_DEC = 0, B_Y0 = 128 * MiB, B_POST = 0;

struct Params { const float* in[34]; int ph_lo, ph_hi; };

__device__ __forceinline__ unsigned pk2(float lo, float hi) { return pg8::cvt_pk_bf16(lo, hi); }
__device__ __forceinline__ float bflo(unsigned w) { return __uint_as_float(w << 16); }
__device__ __forceinline__ float bfhi(unsigned w) { return __uint_as_float(w & 0xffff0000u); }
__device__ __forceinline__ f32x4 ld_bf4(const bf16_t* p) { const u32x2 w = *(const u32x2*)p; return (f32x4){bflo(w.x), bfhi(w.x), bflo(w.y), bfhi(w.y)}; }
__device__ __forceinline__ f32x4 un_bf4(u32x2 w) { return (f32x4){bflo(w.x), bfhi(w.x), bflo(w.y), bfhi(w.y)}; }
__device__ __forceinline__ void st_bf4(bf16_t* p, f32x4 v) { u32x2 w; w.x = pk2(v.x, v.y); w.y = pk2(v.z, v.w); *(u32x2*)p = w; }
__device__ __forceinline__ float wave_sum(float v) {
#pragma unroll
    for (int o = 1; o < 64; o <<= 1) v += __shfl_xor(v, o);
    return v;
}
__device__ __forceinline__ float sum16(float v) {
#pragma unroll
    for (int o = 1; o < 16; o <<= 1) v += __shfl_xor(v, o);
    return v;
}
__device__ __forceinline__ float dot4(f32x4 a, f32x4 b) { return (a.x * b.x + a.y * b.y) + (a.z * b.z + a.w * b.w); }
template <int CTRL> __device__ __forceinline__ float dpp_mov(float v) { return __int_as_float(__builtin_amdgcn_update_dpp(0, __float_as_int(v), CTRL, 0xf, 0xf, false)); }
__device__ __forceinline__ float row_sum16(float p) {
    p += dpp_mov<0xB1>(p); p += dpp_mov<0x4E>(p); p += dpp_mov<0x141>(p); p += dpp_mov<0x140>(p); return p;
}
#define LDS_WAIT() asm volatile("s_waitcnt lgkmcnt(0)" ::: "memory")

#define XB_TMO      128
#define XB_XCNT(j)  (256  + 64 * (j))
#define XB_XSUB(j)  (1280 + 64 * (j))
#define XB_XGEN(j)  (2304 + 64 * (j))
#define XB_TOP      3328
#define XB_TOPGEN   3392
#define XCD_BAR_WORDS 3456
#define XB_SPIN_CAP (1u << 18)

__device__ __forceinline__ unsigned xb_ld(unsigned* p)              { return __hip_atomic_load(p, __ATOMIC_RELAXED, __HIP_MEMORY_SCOPE_AGENT); }
__device__ __forceinline__ unsigned xb_add(unsigned* p, unsigned v) { return __hip_atomic_fetch_add(p, v, __ATOMIC_RELAXED, __HIP_MEMORY_SCOPE_AGENT); }
__device__ __forceinline__ unsigned xb_xcc_id() { return (unsigned)__builtin_amdgcn_s_getreg((3 << 11) | 20) & 0xFu; }
#define XB_SPIN(cond, bar) do { unsigned _sp = 0; while (cond) { __builtin_amdgcn_s_sleep(1); \
    if ((++_sp & 255u) == 0u) { if (xb_ld(&(bar)[XB_TMO])) break; if (_sp > XB_SPIN_CAP) { atomicAdd(&(bar)[XB_TMO], 1u); break; } } } } while (0)

struct XcdBarrier {
    unsigned* bar; unsigned x;
    volatile LAS unsigned* st;
};

__device__ __forceinline__ XcdBarrier xcd_barrier_post(unsigned* bar, volatile LAS unsigned* st) {
    XcdBarrier b; b.bar = bar; b.x = xb_xcc_id(); b.st = st;
    if (threadIdx.x == 0) (void)xb_add(&bar[XB_XCNT(b.x)], 1u);
    return b;
}
__device__ __forceinline__ void xcd_barrier_complete(unsigned* bar, unsigned x, unsigned& nloc, unsigned& nx) {
    const unsigned G = gridDim.x * gridDim.y * gridDim.z;
    unsigned sum, cnt, mine, sp = 0u;
    for (;;) {
        sum = 0u; cnt = 0u; mine = 0u;
#pragma unroll
        for (unsigned j = 0; j < 16; ++j) { const unsigned c = xb_ld(&bar[XB_XCNT(j)]); sum += c; cnt += (c > 0u) ? 1u : 0u; mine = (j == x) ? c : mine; }
        if (sum == G) break;
        __builtin_amdgcn_s_sleep(1);
        if ((++sp & 255u) == 0u) { if (xb_ld(&bar[XB_TMO])) break; if (sp > XB_SPIN_CAP) { atomicAdd(&bar[XB_TMO], 1u); break; } }
    }
    nloc = mine > 0u ? mine : 1u; nx = cnt > 0u ? cnt : 1u;
}

__device__ __forceinline__ void xcd_barrier(const XcdBarrier& b) {
    asm volatile("s_waitcnt vmcnt(0)" ::: "memory");
    __syncthreads();
    if (threadIdx.x == 0) {
        unsigned* bar = b.bar;
        __builtin_amdgcn_s_waitcnt(0);
        unsigned nloc = b.st[0], nx = b.st[1];
        if (nloc == 0u) { xcd_barrier_complete(bar, b.x, nloc, nx); b.st[0] = nloc; b.st[1] = nx; }
        const unsigned old = xb_add(&bar[XB_XSUB(b.x)], 1u);
        const unsigned gen = old / nloc;
        if (old + 1u == (gen + 1u) * nloc) {
            __builtin_amdgcn_fence(__ATOMIC_RELEASE, "agent");
            asm volatile("s_waitcnt vmcnt(0)" ::: "memory");
            const unsigned og = xb_add(&bar[XB_TOP], 1u);
            const unsigned tg = og / nx;
            if (og + 1u == (tg + 1u) * nx) xb_add(&bar[XB_TOPGEN], 1u);
            else XB_SPIN(xb_ld(&bar[XB_TOPGEN]) == tg, bar);
            __builtin_amdgcn_fence(__ATOMIC_ACQUIRE, "agent");
            xb_add(&bar[XB_XGEN(b.x)], 1u);
            asm volatile("s_waitcnt vmcnt(0)" ::: "memory");
        } else {
            XB_SPIN(xb_ld(&bar[XB_XGEN(b.x)]) == gen, bar);
            __builtin_amdgcn_fence(__ATOMIC_ACQUIRE, "agent");
            asm volatile("s_waitcnt vmcnt(0)" ::: "memory");
        }
    }
    __syncthreads();
}


__device__ __forceinline__ void transpose_item(const float* W, int K, int N, bf16_t* WT, int mode, LAS float* scr, int item, int lane) {
    const int nblk = N / 32, kb = item / nblk, nb = item % nblk, k0 = 64 * kb, n0 = 32 * nb;
    const int drow0 = (mode == 0) ? n0 : ((n0 >> 7) * 256 + (n0 & 127) + (mode == 2 ? 128 : 0));
    float tv[32];
#pragma unroll
    for (int i = 0; i < 32; ++i) tv[i] = W[(size_t)(k0 + 2 * i + (lane >> 5)) * N + n0 + (lane & 31)];
#pragma unroll
    for (int i = 0; i < 32; ++i) scr[(2 * i + (lane >> 5)) * 33 + (lane & 31)] = tv[i];
    LDS_WAIT();
    const int c = lane & 7;
#pragma unroll
    for (int j = 0; j < 4; ++j) { const int n = (lane >> 3) + 8 * j; const LAS float* s = scr + (8 * c) * 33 + n;
        u32x4 o; o.x = pk2(s[0 * 33], s[1 * 33]); o.y = pk2(s[2 * 33], s[3 * 33]); o.z = pk2(s[4 * 33], s[5 * 33]); o.w = pk2(s[6 * 33], s[7 * 33]);
        *(u32x4*)(WT + (size_t)(drow0 + n) * K + k0 + 8 * c) = o; }
    LDS_WAIT();
}
struct TJob { const float* src; bf16_t* dst; int K, N, mode, nitems; };
__device__ __forceinline__ TJob get_job(const Params& P, int z, unsigned char* ws, int L, int jb) {
    TJob j; unsigned char* wb = ws + WS_W; const int jm = L >> 1; const bool attn = !(L & 1);
    if (jb < 6) {
        const int f = jb / 3, q = jb % 3; const size_t wo = (size_t)(L * 2 + f) * DM * DFF;
        if (q == 0)      { j.src = P.in[5 + z] + wo; j.K = DM; j.N = DFF; j.mode = 1; j.dst = (bf16_t*)(wb + (f ? W_F1G : W_F0G)); }
        else if (q == 1) { j.src = P.in[6 + z] + wo; j.K = DM; j.N = DFF; j.mode = 2; j.dst = (bf16_t*)(wb + (f ? W_F1G : W_F0G)); }
        else             { j.src = P.in[7 + z] + wo; j.K = DFF; j.N = DM; j.mode = 0; j.dst = (bf16_t*)(wb + (f ? W_F1D : W_F0D)); }
    } else if (attn) {
        j.mode = 0; j.K = DM;
        if (jb == 6) { j.src = P.in[8 + z] + (size_t)jm * DM * NQKV; j.N = NQKV; j.dst = (bf16_t*)(wb + W_MX + MX_QKV); }
        else         { j.src = P.in[11 + z] + (size_t)jm * DM * DM; j.N = DM; j.dst = (bf16_t*)(wb + W_MX + MX_AWO); }
    } else {
        j.mode = 0; j.K = DM; j.N = DM;
        if (jb < 9) { j.src = P.in[13 + z] + (size_t)(jm * 3 + (jb - 6)) * DM * DM; j.dst = (bf16_t*)(wb + W_MX + MX_WR + (size_t)(jb - 6) * 2 * MiB); }
        else        { j.src = P.in[27 + z] + (size_t)jm * DM * DM; j.dst = (bf16_t*)(wb + W_MX + MX_RWO); }
    }
    j.nitems = (j.K / 64) * (j.N / 32);
    return j;
}
__device__ __forceinline__ void fill_l1(bf16_t* dst, const float* src, int nsrc, int rank, int gtid, int gthreads) {
    for (int i = gtid; i < 256 * 512; i += gthreads) { const int n = i >> 9, k = (i & 511) * 2; float a = 0.f, b = 0.f;
        if (n < nsrc * rank) { const float* s = src + (size_t)(n / rank) * 1024 * rank + (n % rank); a = s[(size_t)k * rank]; b = s[(size_t)(k + 1) * rank]; }
        ((unsigned*)dst)[i] = pk2(a, b); }
}
__device__ __forceinline__ void fill_l2bd(bf16_t* dst, const float* src, int gtid, int gthreads) {
    for (int i = gtid; i < 2048 * 64; i += gthreads) { const int n = i >> 6, k = (i & 63) * 2, dir = n >> 10, col = n & 1023, kk = k - 64 * dir; float a = 0.f, b = 0.f;
        if (kk >= 0 && kk < 64) { a = src[(size_t)(dir * 64 + kk) * 1024 + col]; b = src[(size_t)(dir * 64 + kk + 1) * 1024 + col]; }
        ((unsigned*)dst)[i] = pk2(a, b); }
}
__device__ __forceinline__ void fill_l2(bf16_t* dst, const float* src, int rank, int gtid, int gthreads) {
    for (int i = gtid; i < 1024 * 64; i += gthreads) { const int n = i >> 6, k = (i & 63) * 2; float a = 0.f, b = 0.f;
        if (k < rank) { a = src[(size_t)k * 1024 + n]; b = src[(size_t)(k + 1) * 1024 + n]; }
        ((unsigned*)dst)[i] = pk2(a, b); }
}
__device__ __forceinline__ void mods_phase(const Params& P, int z, unsigned char* ws, LAS unsigned char* lds, int tid, int bid, int gdim) {
    LAS float* cs = (LAS float*)lds;
    LAS float* red = cs + 2048;
    float* MOD = (float*)(ws + WS_MOD);
    for (int i = tid; i < 2048; i += NTHR) { const float c = P.in[1 + z][i]; cs[i] = c * pg8::fsigmoid(c); }
    __syncthreads();
    const int cgi = tid & 31, dp = tid >> 5;
    for (int item = bid; item < 4 * 72; item += gdim) {
        const int l = item / 72, cb = item % 72, col = cb * 128 + cgi * 4;
        const float* w = P.in[2 + z] + (size_t)l * DM * 9216 + (size_t)(dp * 64) * 9216 + col;
        f32x4 a0 = (f32x4){0.f, 0.f, 0.f, 0.f}, a1 = a0;
#pragma unroll 8
        for (int d = 0; d < 64; ++d) { const f32x4 wv = *(const f32x4*)(w + (size_t)d * 9216); const float c0 = cs[dp * 64 + d], c1 = cs[1024 + dp * 64 + d]; a0 += wv * c0; a1 += wv * c1; }
        *(LAS f32x4*)(red + (dp * 32 + cgi) * 8) = a0; *(LAS f32x4*)(red + (dp * 32 + cgi) * 8 + 4) = a1;
        __syncthreads();
        if (tid < 256) { const int ci = tid >> 3, e = tid & 7; float s = 0.f;
#pragma unroll
            for (int p = 0; p < 16; ++p) s += red[(p * 32 + ci) * 8 + e];
            const int b = e >> 2, cc = cb * 128 + ci * 4 + (e & 3);
            MOD[(size_t)(l * 2 + b) * 9216 + cc] = s + P.in[3 + z][(size_t)l * 9216 + cc]; }
        __syncthreads();
    }
}
__device__ __forceinline__ const float* mod_vec(unsigned char* ws, int L, int j) { return (const float*)(ws + WS_MOD) + (size_t)(L * 2) * 9216 + (size_t)j * 1024; }

__device__ __forceinline__ void norm_phase(const float* x, bf16_t* H, const float* g, const float* sh, const float* sc, int gw, int ngw, int lane) {
    for (int m0v = gw * 4; m0v < TT; m0v += ngw * 4) {
        const int m0 = __builtin_amdgcn_readfirstlane(m0v);
        const int b = m0 >> 13; const float* xr = x + (size_t)m0 * DM + 4 * lane;
        f32x4 v[4][4];
#pragma unroll
        for (int r = 0; r < 4; ++r)
#pragma unroll
            for (int j = 0; j < 4; ++j) v[r][j] = *(const f32x4*)(xr + (size_t)r * DM + 256 * j);
        f32x4 gs[4], sv[4];
#pragma unroll
        for (int j = 0; j < 4; ++j) { const int c = 4 * lane + 256 * j; gs[j] = *(const f32x4*)(g + c) * (1.0f + *(const f32x4*)(sc + b * 9216 + c)); sv[j] = *(const f32x4*)(sh + b * 9216 + c); }
#pragma unroll
        for (int r = 0; r < 4; ++r) {
            float ss = 0.f;
#pragma unroll
            for (int j = 0; j < 4; ++j) ss += dot4(v[r][j], v[r][j]);
            const float rstd = 1.0f / sqrtf(wave_sum(ss) * (1.0f / DM) + 1e-6f);
#pragma unroll
            for (int j = 0; j < 4; ++j) st_bf4(H + (size_t)(m0 + r) * DM + 4 * lane + 256 * j, v[r][j] * rstd * gs[j] + sv[j]);
        }
    }
}
__device__ __forceinline__ void final_norm_phase(float* x, const float* g, int gw, int ngw, int lane) {
    for (int m0v = gw * 4; m0v < TT; m0v += ngw * 4) {
        const int m0 = __builtin_amdgcn_readfirstlane(m0v);
        float* xr = x + (size_t)m0 * DM + 4 * lane;
        f32x4 v[4][4];
#pragma unroll
        for (int r = 0; r < 4; ++r)
#pragma unroll
            for (int j = 0; j < 4; ++j) v[r][j] = *(const f32x4*)(xr + (size_t)r * DM + 256 * j);
        f32x4 gv[4];
#pragma unroll
        for (int j = 0; j < 4; ++j) gv[j] = *(const f32x4*)(g + 4 * lane + 256 * j);
#pragma unroll
        for (int r = 0; r < 4; ++r) {
            float ss = 0.f;
#pragma unroll
            for (int j = 0; j < 4; ++j) ss += dot4(v[r][j], v[r][j]);
            const float rstd = 1.0f / sqrtf(wave_sum(ss) * (1.0f / DM) + 1e-6f);
#pragma unroll
            for (int j = 0; j < 4; ++j) *(f32x4*)(xr + (size_t)r * DM + 256 * j) = v[r][j] * rstd * gv[j];
        }
    }
}
__device__ __forceinline__ void mix_phase(const float* x, bf16_t* MIX, const float* g, const float* sh, const float* sc, const float* mix, int gw, int ngw, int lane) {
    for (int m = gw; m < TT; m += ngw) {
        const int b = m >> 13, t = m & (SEQ - 1); const bool hp = t > 0, hn = t < SEQ - 1;
        const float* xr = x + (size_t)m * DM + 4 * lane;
        f32x4 vc[4], vp[4], vn[4]; float sc_ = 0.f, sp_ = 0.f, sn_ = 0.f;
#pragma unroll
        for (int j = 0; j < 4; ++j) {
            vc[j] = *(const f32x4*)(xr + 256 * j);
            vp[j] = hp ? *(const f32x4*)(xr - DM + 256 * j) : (f32x4){0.f, 0.f, 0.f, 0.f};
            vn[j] = hn ? *(const f32x4*)(xr + DM + 256 * j) : (f32x4){0.f, 0.f, 0.f, 0.f};
            sc_ += dot4(vc[j], vc[j]); sp_ += dot4(vp[j], vp[j]); sn_ += dot4(vn[j], vn[j]);
        }
        const float rc = 1.0f / sqrtf(wave_sum(sc_) * (1.0f / DM) + 1e-6f), rp = 1.0f / sqrtf(wave_sum(sp_) * (1.0f / DM) + 1e-6f), rn = 1.0f / sqrtf(wave_sum(sn_) * (1.0f / DM) + 1e-6f);
#pragma unroll
        for (int j = 0; j < 4; ++j) { const int c = 4 * lane + 256 * j;
            const f32x4 gv = *(const f32x4*)(g + c) * (1.0f + *(const f32x4*)(sc + b * 9216 + c)), shv = *(const f32x4*)(sh + b * 9216 + c);
            const f32x4 h = vc[j] * rc * gv + shv;
            const f32x4 p = hp ? vp[j] * rp * gv + shv : (f32x4){0.f, 0.f, 0.f, 0.f};
            const f32x4 n = hn ? vn[j] * rn * gv + shv : (f32x4){0.f, 0.f, 0.f, 0.f};
            const f32x4 xx = 0.5f * (p + n) - h;
#pragma unroll
            for (int q = 0; q < 6; ++q) { const f32x4 mv = *(const f32x4*)(mix + q * DM + c); st_bf4(MIX + (size_t)q * TT * DM + (size_t)m * DM + c, h + xx * mv); }
        }
    }
}
__device__ __forceinline__ void qkrope_phase(bf16_t* QKV, const float* qg, const float* kg, int gw, int ngw, int lane) {
    const int sub = lane & 15, hq = lane >> 4;
    float invf[4];
#pragma unroll
    for (int j = 0; j < 4; ++j) invf[j] = __builtin_amdgcn_exp2f(-(float)((sub * 4 + j) & 31) * 0.4152410118609203f) * 0.15915494309189535f;
    const f32x4 q0 = *(const f32x4*)(qg + sub * 8), q1 = *(const f32x4*)(qg + sub * 8 + 4), k0 = *(const f32x4*)(kg + sub * 8), k1 = *(const f32x4*)(kg + sub * 8 + 4);
    constexpr int NIT = TT * 10 / 4;
    for (int it0 = gw * 2; it0 < NIT; it0 += ngw * 2) {
        u32x4 w[2]; int mm[2], hh[2];
#pragma unroll
        for (int u = 0; u < 2; ++u) { const int gh = (it0 + u) * 4 + hq; mm[u] = gh / 10; hh[u] = gh - mm[u] * 10; w[u] = *(const u32x4*)(QKV + (size_t)mm[u] * NQKV + hh[u] * 128 + sub * 8); }
#pragma unroll
        for (int u = 0; u < 2; ++u) {
            const int t = mm[u] & (SEQ - 1);
            f32x4 a = (f32x4){bflo(w[u].x), bfhi(w[u].x), bflo(w[u].y), bfhi(w[u].y)}, bq = (f32x4){bflo(w[u].z), bfhi(w[u].z), bflo(w[u].w), bfhi(w[u].w)};
            const float rstd = 1.0f / sqrtf(row_sum16(dot4(a, a) + dot4(bq, bq)) * (1.0f / 128.0f) + 1e-6f);
            const bool isq = hh[u] < 8;
            a = a * rstd * (isq ? q0 : k0); bq = bq * rstd * (isq ? q1 : k1);
            const float pos = (sub < 8) ? (float)((t >> 6) - 64) : (float)((t & 63) - 32);
            float o[8]; const float in[8] = {a.x, a.y, a.z, a.w, bq.x, bq.y, bq.z, bq.w};
#pragma unroll
            for (int j = 0; j < 4; ++j) { float rev = pos * invf[j]; rev -= rintf(rev); const float s = __builtin_amdgcn_sinf(rev), cs = __builtin_amdgcn_cosf(rev);
                o[2 * j] = in[2 * j] * cs - in[2 * j + 1] * s; o[2 * j + 1] = in[2 * j] * s + in[2 * j + 1] * cs; }
            u32x4 ov; ov.x = pk2(o[0], o[1]); ov.y = pk2(o[2], o[3]); ov.z = pk2(o[4], o[5]); ov.w = pk2(o[6], o[7]);
            *(u32x4*)(QKV + (size_t)mm[u] * NQKV + hh[u] * 128 + sub * 8) = ov;
        }
    }
}
struct PostIn { const float *Y0, *Y1; const bf16_t *R, *K, *V, *A, *G, *VF, *VG; const float *k_a, *r_k, *ln_w, *ln_b; bf16_t* O; int has_vres; };
__device__ __forceinline__ void post_phase(const PostIn& I, int gw, int ngw, int lane) {
    for (int mv = gw; mv < TT; mv += ngw) {
        const int m = __builtin_amdgcn_readfirstlane(mv);
        f32x4 y[4]; u32x2 r_[4], k_[4], v_[4], a0_[4], a1_[4], g_[4], vf_[4], vg_[4];
#pragma unroll
        for (int j = 0; j < 4; ++j) { const int c = 4 * lane + 256 * j; const size_t o = (size_t)m * DM + c;
            y[j] = *(const f32x4*)(I.Y0 + o) + *(const f32x4*)(I.Y1 + o);
            r_[j] = *(const u32x2*)(I.R + o); k_[j] = *(const u32x2*)(I.K + o); v_[j] = *(const u32x2*)(I.V + o); g_[j] = *(const u32x2*)(I.G + o);
            a0_[j] = *(const u32x2*)(I.A + (size_t)m * 2048 + c); a1_[j] = *(const u32x2*)(I.A + (size_t)m * 2048 + 1024 + c);
            if (I.has_vres) { vf_[j] = *(const u32x2*)(I.VF + o); vg_[j] = *(const u32x2*)(I.VG + o); } }
#pragma unroll
        for (int j = 0; j < 4; ++j) { const int c = 4 * lane + 256 * j; const size_t o = (size_t)m * DM + c;
            const float mu = row_sum16((y[j].x + y[j].y) + (y[j].z + y[j].w)) * (1.0f / 64.0f);
            const f32x4 d = y[j] - mu;
            const float var = row_sum16(dot4(d, d)) * (1.0f / 64.0f);
            const float rs = 1.0f / sqrtf(var + 64e-5f);
            const f32x4 r = un_bf4(r_[j]), k = un_bf4(k_[j]); f32x4 v = un_bf4(v_[j]);
            const f32x4 a0 = un_bf4(a0_[j]), a1 = un_bf4(a1_[j]);
            const f32x4 ka = *(const f32x4*)(I.k_a + c), rk = *(const f32x4*)(I.r_k + c);
            if (I.has_vres) { const f32x4 vf = un_bf4(vf_[j]), vg = un_bf4(vg_[j]); v = v + (vf - v) * vg; }
            const f32x4 kd = k * (1.0f + (a0 - 1.0f) * ka) + k * (1.0f + (a1 - 1.0f) * ka);
            const float bonus = row_sum16(dot4(r * kd, rk));
            const f32x4 lw = *(const f32x4*)(I.ln_w + c), lb = *(const f32x4*)(I.ln_b + c), gg = un_bf4(g_[j]);
            st_bf4(I.O + o, (d * rs * lw + lb + bonus * v) * gg);
        }
    }
}
constexpr int TC = 32, SC_ARR = TC * 64 * 4, SC_E = 5 * SC_ARR, SC_Y = SC_E + TC * 16 * 16, SC_BUF = SC_Y + TC * 16 * 4;
struct ScanIn { const bf16_t *R, *K, *V, *A, *VF, *VG; const float* DEC; float *Y0, *Y1; const float *k_k, *k_a; int has_vres; };
struct ScanRegs { u32x2 r, k, v, a, vf, vg; f32x4 dec; };
__device__ __forceinline__ void scan_load(const ScanIn& I, ScanRegs (&rg)[2], int c, int st, int dir, int b, int h, int rq) {
#pragma unroll
    for (int i = 0; i < 2; ++i) { const int item = st + 256 * i, tl = item >> 4, c4 = (item & 15) * 4, ts = c * TC + tl, ta = dir ? SEQ - 1 - ts : ts;
        const size_t grow = (size_t)b * SEQ + ta, o = grow * DM + h * 64 + c4, o2 = grow * 2048 + dir * 1024 + h * 64 + c4;
        rg[i].r = *(const u32x2*)(I.R + o); rg[i].k = *(const u32x2*)(I.K + o); rg[i].v = *(const u32x2*)(I.V + o);
        rg[i].a = *(const u32x2*)(I.A + o2); rg[i].dec = *(const f32x4*)(I.DEC + o2);
        if (I.has_vres && (c4 >> 4) == rq) { rg[i].vf = *(const u32x2*)(I.VF + o); rg[i].vg = *(const u32x2*)(I.VG + o); } }
}
__device__ __forceinline__ void scan_stage(const ScanIn& I, const ScanRegs (&rg)[2], LAS unsigned char* buf, int st, int rq, f32x4 kkv, f32x4 kav) {
#pragma unroll
    for (int i = 0; i < 2; ++i) { const int item = st + 256 * i, tl = item >> 4, c4 = (item & 15) * 4;
        const f32x4 k = un_bf4(rg[i].k), a = un_bf4(rg[i].a), r = un_bf4(rg[i].r);
        const f32x4 kks = k * kkv; const float ss = row_sum16(dot4(kks, kks)); const float inv = 1.0f / fmaxf(sqrtf(ss), 1e-12f);
        const f32x4 kk = kks * inv, kd = k * (1.0f + (a - 1.0f) * kav), ka = kk * a;
        LAS f32x4* base = (LAS f32x4*)(buf + (tl * 64 + c4) * 4);
        base[0] = rg[i].dec; base[SC_ARR / 16] = kk; base[2 * SC_ARR / 16] = ka; base[3 * SC_ARR / 16] = kd; base[4 * SC_ARR / 16] = rg[i].dec * r;
        const float c1 = row_sum16(dot4(ka, r)), c2 = row_sum16(dot4(kd, r));
        if ((c4 >> 4) == rq) { f32x4 v = un_bf4(rg[i].v); if (I.has_vres) { const f32x4 vf = un_bf4(rg[i].vf), vg = un_bf4(rg[i].vg); v = v + (vf - v) * vg; }
            LAS f32x4* e = (LAS f32x4*)(buf + SC_E + (tl * 16 + (c4 & 15)) * 16);
            e[0] = (f32x4){v.x, c1, c2, 0.f}; e[1] = (f32x4){v.y, c1, c2, 0.f}; e[2] = (f32x4){v.z, c1, c2, 0.f}; e[3] = (f32x4){v.w, c1, c2, 0.f}; } }
}
__device__ __forceinline__ void scan_writey(const ScanIn& I, const LAS unsigned char* buf, int c, int st, int dir, int b, int h, int rq) {
    const LAS float* yb = (const LAS float*)(buf + SC_Y); float* Y = dir ? I.Y1 : I.Y0;
#pragma unroll
    for (int i = 0; i < 2; ++i) { const int item = st + 256 * i, tl = item >> 4, rl = item & 15, ts = c * TC + tl, ta = dir ? SEQ - 1 - ts : ts;
        Y[((size_t)b * SEQ + ta) * DM + h * 64 + rq * 16 + rl] = yb[item]; }
}
__device__ __forceinline__ void scan_unit(const ScanIn& I, LAS unsigned char* lds, int unit, int tid) {
    const int dir = unit >> 7, b = (unit >> 6) & 1, h = (unit >> 2) & 15, rq = unit & 3;
    constexpr int NC = SEQ / TC;
    const bool stager = tid >= 256; const int st = tid & 255, vt = st;
    f32x4 s = (f32x4){0.f, 0.f, 0.f, 0.f};
    ScanRegs rg[2]; f32x4 kkv = s, kav = s;
    if (stager) { const int c4 = (st & 15) * 4; kkv = *(const f32x4*)(I.k_k + h * 64 + c4); kav = *(const f32x4*)(I.k_a + h * 64 + c4);
        scan_load(I, rg, 0, st, dir, b, h, rq); scan_stage(I, rg, lds, st, rq, kkv, kav); scan_load(I, rg, 1, st, dir, b, h, rq); }
    __syncthreads();
    for (int c = 0; c < NC; ++c) {
        LAS unsigned char* cur = lds + (c & 1) * SC_BUF; LAS unsigned char* nxt = lds + ((c + 1) & 1) * SC_BUF;
        if (stager) {
            ScanRegs cr[2]; cr[0] = rg[0]; cr[1] = rg[1];
            asm volatile("" : "+v"(cr[0].dec), "+v"(cr[1].dec), "+v"(cr[0].k), "+v"(cr[1].k), "+v"(cr[0].r), "+v"(cr[1].r), "+v"(cr[0].a), "+v"(cr[1].a), "+v"(cr[0].v), "+v"(cr[1].v));
            __builtin_amdgcn_sched_barrier(0);
            if (c + 2 < NC) scan_load(I, rg, c + 2, st, dir, b, h, rq);
            __builtin_amdgcn_sched_barrier(0);
            if (c + 1 < NC) scan_stage(I, cr, nxt, st, rq, kkv, kav);
            if (c > 0) scan_writey(I, nxt, c - 1, st, dir, b, h, rq);
        } else {
            const int rl = vt >> 4, ks = vt & 15;
            const unsigned abase = (unsigned)(uintptr_t)(cur + ks * 16), ebase = (unsigned)(uintptr_t)(cur + SC_E + rl * 16);
            LAS float* yb = (LAS float*)(cur + SC_Y) + rl;
#define DSR(dst, addr, off) asm volatile("ds_read_b128 %0, %1 offset:%2" : "=v"(dst) : "v"(addr), "i"(off) : "memory")
#define SCAN_LD(X, TL) do { if constexpr ((TL) < TC) { constexpr int tl_ = ((TL) < TC) ? (TL) : TC - 1; DSR(X##w, abase, tl_ * 256); DSR(X##kk, abase, tl_ * 256 + SC_ARR); DSR(X##ka, abase, tl_ * 256 + 2 * SC_ARR); \
        DSR(X##kd, abase, tl_ * 256 + 3 * SC_ARR); DSR(X##wr, abase, tl_ * 256 + 4 * SC_ARR); DSR(X##e, ebase, tl_ * 256); } } while (0)
#define SCAN_WAIT(X, T) do { if constexpr ((T) + 1 < TC) asm volatile("s_waitcnt lgkmcnt(6)" : "+v"(X##w), "+v"(X##kk), "+v"(X##ka), "+v"(X##kd), "+v"(X##wr), "+v"(X##e) :: "memory"); \
        else asm volatile("s_waitcnt lgkmcnt(0)" : "+v"(X##w), "+v"(X##kk), "+v"(X##ka), "+v"(X##kd), "+v"(X##wr), "+v"(X##e) :: "memory"); } while (0)
#define SCAN_STEP(X, N, T) do { SCAN_WAIT(X, T); SCAN_LD(N, (T) + 2); \
        f32x2 pa = s.xy * X##kk.xy; pa = s.zw * X##kk.zw + pa; f32x2 pb = s.xy * X##wr.xy; pb = s.zw * X##wr.zw + pb; \
        float p1 = pa.x + pa.y, p2 = pb.x + pb.y;                   \
        p1 += dpp_mov<0xB1>(p1); p2 += dpp_mov<0xB1>(p2); p1 += dpp_mov<0x4E>(p1); p2 += dpp_mov<0x4E>(p2); \
        p1 += dpp_mov<0x141>(p1); p2 += dpp_mov<0x141>(p2); p1 += dpp_mov<0x140>(p1); p2 += dpp_mov<0x140>(p2); \
        const float sa = -p1, vv = X##e.x; \
        f32x2 ua = vv * X##kd.xy, ub = vv * X##kd.zw; ua = sa * X##ka.xy + ua; ub = sa * X##ka.zw + ub; \
        s.xy = s.xy * X##w.xy + ua; s.zw = s.zw * X##w.zw + ub; \
        const float y = p2 + (sa * X##e.y + vv * X##e.z); \
        yacc = (ks == ((T) & 15)) ? y : yacc; } while (0)
#define SCAN_QUAD(T) do { SCAN_STEP(A, C, (T)); SCAN_STEP(B, D, (T) + 1); SCAN_STEP(C, A, (T) + 2); SCAN_STEP(D, B, (T) + 3); } while (0)
            f32x4 Aw, Akk, Aka, Akd, Awr, Ae, Bw, Bkk, Bka, Bkd, Bwr, Be, Cw, Ckk, Cka, Ckd, Cwr, Ce, Dw, Dkk, Dka, Dkd, Dwr, De;
            SCAN_LD(A, 0); SCAN_LD(B, 1);
            float yacc = 0.f;
            SCAN_QUAD(0); SCAN_QUAD(4); SCAN_QUAD(8); SCAN_QUAD(12);
            yb[ks * 16] = yacc;
            SCAN_QUAD(16); SCAN_QUAD(20); SCAN_QUAD(24); SCAN_QUAD(28);
            yb[(16 + ks) * 16] = yacc;
            asm volatile("s_waitcnt lgkmcnt(0)" ::: "memory");
#undef DSR
#undef SCAN_LD
#undef SCAN_WAIT
#undef SCAN_STEP
#undef SCAN_QUAD
        }
        __syncthreads();
    }
    if (stager) scan_writey(I, lds + ((NC - 1) & 1) * SC_BUF, NC - 1, st, dir, b, h, rq);
    __syncthreads();
}

#define MK_REP_ATT 1
#define MK_REP_SCAN 1
#define MK_REP_SYNC 1
#define MK_REP_SMALL 1
constexpr int PH_PER_LAYER = 13, NPHASES = DEPTH * PH_PER_LAYER + 1;

__global__ void __launch_bounds__(NTHR, 2) fwd_megakernel(Params P) {
    extern __shared__ __attribute__((aligned(16))) unsigned char lds_raw[];
    cg::grid_group grid = cg::this_grid();
    LAS unsigned char* lds = (LAS unsigned char*)lds_raw;

    volatile LAS unsigned* MISC = (volatile LAS unsigned*)(lds + LDS_BYTES - 64);
    if (threadIdx.x < 16) MISC[threadIdx.x] = 0u;
    __syncthreads();
    const XcdBarrier bar = xcd_barrier_post((unsigned*)P.in[33], MISC);
    for (int ph = P.ph_lo; ph < P.ph_hi; ++ph) {
        int bid = blockIdx.x, gdim = gridDim.x; asm volatile("" : "+s"(bid), "+s"(gdim));
        int z = 0; asm volatile("" : "+s"(z));
        unsigned char* ws = (unsigned char*)P.in[33 + z];
        float* X = (float*)P.in[32 + z];
        bf16_t* H = (bf16_t*)(ws + WS_H);
        unsigned char* wb = ws + WS_W; unsigned char* big = ws + WS_BIG;
        const int tid = mk_tid(), lane = tid & 63, wave = __builtin_amdgcn_readfirstlane(tid >> 6);
        const int gw = bid * NWAVES + wave, ngw = gdim * NWAVES, gtid = bid * NTHR + tid, gthreads = gdim * NTHR;
        const int L = ph / PH_PER_LAYER, k = ph - L * PH_PER_LAYER, jm = L >> 1;
        const bool attn = !(L & 1);
        if (ph == NPHASES - 1) {
            final_norm_phase(X, P.in[31 + z], gw, ngw, lane);
        } else if (k == 0) {
            LAS float* scr = (LAS float*)(lds + wave * 16384);
            const int njobs = attn ? 8 : 10; int total = 0;
            for (int jb = 0; jb < njobs; ++jb) total += get_job(P, z, ws, L, jb).nitems;
            for (int it = gw; it < total; it += ngw) {
                int r = it;
                for (int jb = 0; jb < njobs; ++jb) { const TJob j = get_job(P, z, ws, L, jb); if (r < j.nitems) { transpose_item(j.src, j.K, j.N, j.dst, j.mode, scr, r, lane); break; } r -= j.nitems; }
            }
            if (!attn) {
                unsigned char* mx = wb + W_MX;
                fill_l1((bf16_t*)(mx + MX_L1), P.in[15 + z] + (size_t)jm * 2 * 1024 * 64, 2, 64, gtid, gthreads);
                fill_l1((bf16_t*)(mx + MX_L1 + 512 * KiB), P.in[18 + z] + (size_t)jm * 2 * 1024 * 64, 2, 64, gtid, gthreads);
                fill_l1((bf16_t*)(mx + MX_L1 + 1024 * KiB), P.in[20 + z] + (size_t)jm * 1024 * 128, 1, 128, gtid, gthreads);
                if (jm > 0) fill_l1((bf16_t*)(mx + MX_L1 + 1536 * KiB), P.in[29 + z] + (size_t)(jm - 1) * 1024 * 32, 1, 32, gtid, gthreads);
                fill_l2bd((bf16_t*)(mx + MX_L2W), P.in[16 + z] + (size_t)jm * 2 * 64 * 1024, gtid, gthreads);
                fill_l2bd((bf16_t*)(mx + MX_L2A), P.in[19 + z] + (size_t)jm * 2 * 64 * 1024, gtid, gthreads);
                fill_l2((bf16_t*)(mx + MX_L2G), P.in[21 + z] + (size_t)jm * 128 * 1024, 128, gtid, gthreads);
                if (jm > 0) fill_l2((bf16_t*)(mx + MX_L2V), P.in[30 + z] + (size_t)(jm - 1) * 32 * 1024, 32, gtid, gthreads);
            }
            if (L == 0) { __syncthreads(); mods_phase(P, z, ws, lds, tid, bid, gdim); }
        } else if (k == 1 || k == 10 || (k == 4 && attn)) {
            const int sub = (k == 1) ? 0 : (k == 4 ? 1 : 2);
            const float* xin = (L == 0 && k == 1) ? P.in[0 + z] : X;
            norm_phase(xin, H, P.in[4 + z] + (size_t)(L * 3 + sub) * DM, mod_vec(ws, L, 3 * sub), mod_vec(ws, L, 3 * sub + 1), gw, ngw, lane);
        } else if (k == 2 || k == 11) {
            const int f = (k == 11);
            pg8::Gemm g{H, (const bf16_t*)(wb + (f ? W_F1G : W_F0G)), TT, 2 * DFF, DM};
            pg8::GenOrder S; S.so.init(TT, 2 * DFF, gdim, bid); S.single = 0; S.pm = 0; S.pn = 0;
            pg8::EpiSwiglu E{(bf16_t*)(big + B_HID), DFF};

#ifndef SKIP_SWI
            pg8::gemm_phase<pg8::EpiSwiglu, pg8::GenOrder, true, true>(lds, g, S, E);
#endif

        } else if (k == 3 || k == 12 || k == 9) {
            pg8::Gemm g; pg8::EpiResid E;
            if (k == 9) {
                g = pg8::Gemm{attn ? H : (const bf16_t*)(big + B_POST), (const bf16_t*)(wb + W_MX + (attn ? MX_AWO : MX_RWO)), TT, DM, DM};
                E = pg8::EpiResid{X, X, mod_vec(ws, L, 5), 9216, 1.0f / MK_REP_GEMM};
            } else {
                const int f = (k == 12);
                g = pg8::Gemm{(const bf16_t*)(big + B_HID), (const bf16_t*)(wb + (f ? W_F1D : W_F0D)), TT, DM, DFF};
                E = pg8::EpiResid{(L == 0 && k == 3) ? P.in[0 + z] : X, X, mod_vec(ws, L, f ? 8 : 2), 9216, (L == 0 && k == 3) ? 0.5f : 0.5f / MK_REP_GEMM};
            }
            pg8::GenOrder S; S.so.init(TT, DM, gdim, bid); S.single = 0; S.pm = 0; S.pn = 0;

#ifndef SKIP_RES
            pg8::gemm_phase<pg8::EpiResid, pg8::GenOrder, true, true>(lds, g, S, E);
#endif

        } else if (k == 4) {
            mix_phase(X, (bf16_t*)(big + B_MIX), P.in[4 + z] + (size_t)(L * 3 + 1) * DM, mod_vec(ws, L, 3), mod_vec(ws, L, 4), P.in[12 + z] + (size_t)jm * 6 * DM, gw, ngw, lane);
        } else if (k == 5 || (k == 6 && !attn)) {
            const int nsub = attn ? 1 : (k == 5 ? 4 : 3);
            bf16_t* vdst = (jm == 0) ? (bf16_t*)(ws + WS_VF) : (bf16_t*)(big + B_V);
            for (int s = 0; s < nsub; ++s) {
                pg8::Gemm g; pg8::EpiBf16Out E; pg8::GenOrder S; S.single = 0; S.pm = 0; S.pn = 0; int N = DM;
                if (attn) { g = pg8::Gemm{H, (const bf16_t*)(wb + W_MX + MX_QKV), TT, NQKV, DM}; E = pg8::EpiBf16Out{(bf16_t*)(big + B_QKV), NQKV, nullptr, 0, NQKV}; N = NQKV; }
                else if (k == 5 && s < 3) {
                    const int mixi = (s == 0) ? 0 : (s == 1 ? 2 : 3);
                    bf16_t* dst = (s == 0) ? (bf16_t*)(big + B_R) : (s == 1 ? (bf16_t*)(big + B_K) : vdst);
                    g = pg8::Gemm{(const bf16_t*)(big + B_MIX) + (size_t)mixi * TT * DM, (const bf16_t*)(wb + W_MX + MX_WR + (size_t)s * 2 * MiB), TT, DM, DM};
                    E = pg8::EpiBf16Out{dst, DM, nullptr, 0, DM};
                } else if (k == 5) {
                    const int q = bid >> 6; const int mixi = (q == 0) ? 1 : (q == 1 ? 4 : (q == 2 ? 5 : 3));
                    g = pg8::Gemm{(const bf16_t*)(big + B_MIX) + (size_t)mixi * TT * DM, (const bf16_t*)(wb + W_MX + MX_L1 + (size_t)q * 512 * KiB), TT, 256, DM};
                    E = pg8::EpiBf16Out{(bf16_t*)(big + B_L1 + (size_t)q * 4 * MiB), 128, nullptr, (q == 0) ? 1 : (q == 2 ? 2 : 0), 128};
                    S.single = 1; S.pm = (bid < 256 && !(q == 3 && jm == 0)) ? (int)(bid & 63) : -1; S.pn = 0; N = 256;
                } else if (s == 0) {
                    g = pg8::Gemm{(const bf16_t*)(big + B_L1 + 4 * MiB), (const bf16_t*)(wb + W_MX + MX_L2A), TT, 2048, 128}; N = 2048;
                    E = pg8::EpiBf16Out{(bf16_t*)(big + B_A), 2048, P.in[17 + z] + (size_t)jm * 2 * DM, 2, 2048};
                } else if (s == 1) {
                    g = pg8::Gemm{(const bf16_t*)(big + B_L1 + 8 * MiB), (const bf16_t*)(wb + W_MX + MX_L2G), TT, DM, 128};
                    E = pg8::EpiBf16Out{(bf16_t*)(big + B_G), DM, nullptr, 0, DM};
                } else {
                    g = pg8::Gemm{(const bf16_t*)(big + B_L1 + 12 * MiB), (const bf16_t*)(wb + W_MX + MX_L2V), TT, DM, 128};
                    E = pg8::EpiBf16Out{H, DM, P.in[28 + z], 2, DM};
                    if (jm == 0) { S.single = 1; S.pm = -1; }
                }
                if (!S.single) S.so.init(TT, N, gdim, bid);

#ifndef SKIP_BF
                pg8::gemm_phase<pg8::EpiBf16Out, pg8::GenOrder, true, false>(lds, g, S, E);
#endif

            }
            if (!attn && k == 6) {
                pg8::Gemm g{(const bf16_t*)(big + B_L1), (const bf16_t*)(wb + W_MX + MX_L2W), TT, 2048, 128};
                pg8::EpiF32Out E{(float*)(big + B_DEC), 2048, P.in[14 + z] + (size_t)jm * 2 * DM, 3};
                pg8::GenOrder S; S.so.init(TT, 2048, gdim, bid); S.single = 0; S.pm = 0; S.pn = 0;

#ifndef SKIP_F32
                pg8::gemm_phase<pg8::EpiF32Out, pg8::GenOrder, true, false>(lds, g, S, E);
#endif

            }
        } else if (k == 6) {
            qkrope_phase((bf16_t*)(big + B_QKV), P.in[9 + z] + (size_t)jm * 128, P.in[10 + z] + (size_t)jm * 128, gw, ngw, lane);
        } else if (k == 7 && attn) {
            const att::bf16* qkv = (const att::bf16*)(big + B_QKV);
            for (int uu = bid; uu < 512 * MK_REP_ATT; uu += gdim) {
                const int u = uu & 511, b = u >> 8, hq = (u >> 5) & 7, qb = u & 31; const size_t r0 = (size_t)b * SEQ;

#ifndef SKIP_ATT
                att::attn_dense_body<att::bf16>(qkv + (r0 + qb * 256) * NQKV + hq * 128, qkv + r0 * NQKV + 1024 + (hq >> 2) * 128, qkv + r0 * NQKV + 1280 + (hq >> 2) * 128,
                                                (att::bf16*)H + (r0 + qb * 256) * DM + hq * 128, SEQ, (char*)lds_raw);
#endif

                __syncthreads();
            }
        } else if (k == 7) {
            ScanIn I; I.R = (const bf16_t*)(big + B_R); I.K = (const bf16_t*)(big + B_K); I.V = (jm == 0) ? (const bf16_t*)(ws + WS_VF) : (const bf16_t*)(big + B_V);
            I.A = (const bf16_t*)(big + B_A); I.VF = (const bf16_t*)(ws + WS_VF); I.VG = H; I.DEC = (const float*)(big + B_DEC);
            I.Y0 = (float*)(big + B_Y0); I.Y1 = (float*)(big + B_Y1); I.k_k = P.in[22 + z] + (size_t)jm * DM; I.k_a = P.in[23 + z] + (size_t)jm * DM; I.has_vres = jm > 0;

#ifndef SKIP_SCAN
            for (int u = bid; u < 256 * MK_REP_SCAN; u += gdim) scan_unit(I, lds, u & 255, tid);
#endif

        } else if (k == 8 && !attn) {
            PostIn I; I.Y0 = (const float*)(big + B_Y0); I.Y1 = (const float*)(big + B_Y1); I.R = (const bf16_t*)(big + B_R); I.K = (const bf16_t*)(big + B_K);
            I.V = (jm == 0) ? (const bf16_t*)(ws + WS_VF) : (const bf16_t*)(big + B_V); I.A = (const bf16_t*)(big + B_A); I.G = (const bf16_t*)(big + B_G);
            I.VF = (const bf16_t*)(ws + WS_VF); I.VG = H; I.k_a = P.in[23 + z] + (size_t)jm * DM; I.r_k = P.in[24 + z] + (size_t)jm * DM; I.ln_w = P.in[25 + z] + (size_t)jm * DM; I.ln_b = P.in[26 + z] + (size_t)jm * DM;
            I.O = (bf16_t*)(big + B_POST); I.has_vres = jm > 0;
            post_phase(I, gw, ngw, lane);
        }
        if (ph + 1 < P.ph_hi) { for (int rr = 0; rr < MK_REP_SYNC; ++rr) { if (ph == P.ph_lo) grid.sync(); else xcd_barrier(bar); } }
    }
}

extern "C" void kernel_launch(void* const* d_in, const int* in_sizes, int n_in, void* d_out, int out_size, void* d_ws, size_t ws_size, hipStream_t stream) {
    static int grid_blocks = 0;
    if (grid_blocks == 0) {
        if (n_in != 32 || out_size != TT * DM || ws_size < WS_END) { fprintf(stderr, "kernel_launch: unexpected shapes: n_in %d out %d ws %zu (need %zu)\n", n_in, out_size, ws_size, (size_t)WS_END); grid_blocks = -1; return; }
        int dev = 0, cus = 0, per_cu = 0;
        hipGetDevice(&dev);
        hipDeviceGetAttribute(&cus, hipDeviceAttributeMultiprocessorCount, dev);
        if (hipFuncSetAttribute((const void*)fwd_megakernel, hipFuncAttributeMaxDynamicSharedMemorySize, LDS_BYTES) != hipSuccess) { fprintf(stderr, "kernel_launch: hipFuncSetAttribute failed\n"); grid_blocks = -1; return; }
        if (hipOccupancyMaxActiveBlocksPerMultiprocessor(&per_cu, (const void*)fwd_megakernel, NTHR, LDS_BYTES) != hipSuccess || per_cu < 1) { fprintf(stderr, "kernel_launch: occupancy query gave %d\n", per_cu); per_cu = 1; }
        (void)hipGetLastError();
        grid_blocks = cus * 1;
        fprintf(stderr, "kernel_launch: cus %d per_cu %d grid %d\n", cus, per_cu, grid_blocks);
    }
    if (grid_blocks < 0) return;
    Params p{};
    for (int i = 0; i < 32; ++i) p.in[i] = (const float*)d_in[i];
    p.in[32] = (const float*)d_out; p.in[33] = (const float*)d_ws;
#ifdef MK_MULTI_LAUNCH
    for (int ph = 0; ph < NPHASES; ++ph) { p.ph_lo = ph; p.ph_hi = ph + 1; hipLaunchKernelGGL(fwd_megakernel, dim3(grid_blocks), dim3(NTHR), LDS_BYTES, stream, p); }
#else
    p.ph_lo = 0; p.ph_hi = NPHASES;
    if (hipMemsetAsync(d_ws, 0, 16384, stream) != hipSuccess) { fprintf(stderr, "kernel_launch: memset of the barrier words failed\n"); return; }
    void* args[] = {&p};
    hipError_t e = hipLaunchCooperativeKernel((const void*)fwd_megakernel, dim3(grid_blocks), dim3(NTHR), args, LDS_BYTES, stream);
    if (e != hipSuccess) fprintf(stderr, "cooperative launch failed: %s (grid %d)\n", hipGetErrorString(e), grid_blocks);
#endif
}
```
